# Optimizing an MI355X kernel written in HIP

```python
import jax, jax.numpy as jnp
from jax import lax
import numpy as np

D_MODEL = 1024
BATCH = 8
SEQ = 4096
DEPTH = 1

GRID_W = 64
CTX_LEN = 256
N_HEADS = 4
D_KEY = D_MODEL // 2
D_VAL = D_MODEL
HEAD_K = D_KEY // N_HEADS
HEAD_V = D_VAL // N_HEADS
DECAY_RANK = 16
DECAY_TAU = 16.0
CHUNK = 64
D_CONV = D_MODEL
CONV_W = 3
D_FF = ((-(-8 * D_MODEL // 3)) + 255) // 256 * 256
EPS = 1e-6
IN_SPLITS = (D_KEY, D_KEY, D_VAL, D_VAL, 2 * DECAY_RANK, D_CONV, D_CONV, D_CONV, D_MODEL, D_MODEL)
N_IN = sum(IN_SPLITS)

kernel_name = "hybrid_gla_shortconv_dit_block"


def rmsnorm(x, g):
    xf = x.astype(jnp.float32)
    y = xf * lax.rsqrt(jnp.mean(xf * xf, axis=-1, keepdims=True) + EPS)
    return (y * g.astype(jnp.float32)).astype(x.dtype)


def modulate(h, shift, scale):
    return h * (1.0 + scale[:, None, :]) + shift[:, None, :]


def gla_chunked(q, k, v, log_a, s0):
    Bn, H, T, K = q.shape
    V = v.shape[-1]
    N = T // CHUNK
    f = lambda t: t.astype(jnp.float32).reshape(Bn, H, N, CHUNK, t.shape[-1])
    q, k, v, log_a = f(q), f(k), f(v), f(log_a)
    q = q * (K ** -0.5)
    b = jnp.cumsum(log_a, axis=3)
    b_mid = b[:, :, :, CHUNK // 2 - 1:CHUNK // 2, :]
    b_last = b[:, :, :, CHUNK - 1:, :]
    causal = jnp.tril(jnp.ones((CHUNK, CHUNK), dtype=bool))
    scores = jnp.einsum('bhnik,bhnjk->bhnij', q * jnp.exp(b - b_mid), k * jnp.exp(b_mid - b))
    scores = jnp.where(causal, scores, 0.0)
    o_intra = jnp.einsum('bhnij,bhnjv->bhniv', scores, v)
    kv = jnp.einsum('bhnjk,bhnjv->nbhkv', k * jnp.exp(b_last - b), v)
    decay = jnp.moveaxis(jnp.exp(b_last[:, :, :, 0, :]), 2, 0)

    def step(s, inp):
        d, kv_n = inp
        return d[..., None] * s + kv_n, s

    s_final, s_before = lax.scan(step, s0.astype(jnp.float32), (decay, kv))
    o_inter = jnp.einsum('bhnik,nbhkv->bhniv', q * jnp.exp(b), s_before)
    return (o_intra + o_inter).reshape(Bn, H, T, V), s_final


def gla_bidir(q, k, v, la_f, la_b, s0_f, s0_b):
    o_f, s_f = gla_chunked(q, k, v, la_f, s0_f)
    flip = lambda t: jnp.flip(t, axis=2)
    o_b, s_b = gla_chunked(flip(q), flip(k), flip(v), flip(la_b), s0_b)
    return o_f + flip(o_b), s_f, s_b


def project(h, w_in, w_dec_up, b_dec):
    Bn, T, _ = h.shape
    z = h @ w_in
    q, k, v, g, dd, cb, cc, ch, ga, gb = jnp.split(z, np.cumsum(IN_SPLITS)[:-1].tolist(), axis=-1)
    dd = dd.reshape(Bn, T, 2, DECAY_RANK)
    zd = jnp.einsum('btdr,drk->dbtk', dd, w_dec_up) + b_dec[:, None, None, :]
    log_a = jax.nn.log_sigmoid(zd.astype(jnp.float32)) / DECAY_TAU
    heads = lambda t, hd: t.reshape(Bn, T, N_HEADS, hd).transpose(0, 2, 1, 3)
    return (heads(q, HEAD_K), heads(k, HEAD_K), heads(v, HEAD_V), g,
            heads(log_a[0], HEAD_K), heads(log_a[1], HEAD_K), cb, cc, ch, ga, gb)


def seq_conv(u, w):
    pad = CONV_W // 2
    T = u.shape[1]
    up = jnp.pad(u, ((0, 0), (pad, pad), (0, 0)))
    y = up[:, 0:T] * w[0]
    for j in range(1, CONV_W):
        y = y + up[:, j:j + T] * w[j]
    return y


def merge_branches(o, g, cb, cc, ch, ga, gb, rows, g_head, w_gla_out, w_conv, w_conv_out, w_mix_out):
    Bn, H, T, V = o.shape
    o = rmsnorm(o, g_head).transpose(0, 2, 1, 3).reshape(Bn, T, H * V).astype(g.dtype)
    y_gla = (o * jax.nn.silu(g)) @ w_gla_out
    u = cc * ch
    if rows is None:
        uc = seq_conv(u, w_conv)
    else:
        uc = seq_conv(u.reshape(Bn * rows, T // rows, -1), w_conv).reshape(Bn, T, -1)
    y_conv = (cb * uc) @ w_conv_out
    merged = jax.nn.sigmoid(ga) * y_gla + jax.nn.sigmoid(gb) * y_conv
    return merged @ w_mix_out


def swiglu(h, w_in, w_out):
    a, b = jnp.split(h @ w_in, 2, axis=-1)
    return (jax.nn.silu(a) * b) @ w_out


def setup_inputs(seed: int = 0) -> dict:
    key = jax.random.key(seed)
    ks = jax.random.split(key, 20)
    nrm = lambda k, shape, s: jax.random.normal(k, shape, jnp.float32) * s
    return {
        "x": nrm(ks[0], (BATCH, SEQ, D_MODEL), 1.0),
        "c": nrm(ks[1], (BATCH, D_MODEL), 1.0),
        "ctx": nrm(ks[2], (BATCH, CTX_LEN, D_MODEL), 1.0),
        "c_ctx": nrm(ks[3], (D_MODEL,), 1.0),
        "w_ada": nrm(ks[4], (DEPTH, D_MODEL, 6 * D_MODEL), 0.5 * D_MODEL ** -0.5),
        "b_ada": nrm(ks[5], (DEPTH, 6 * D_MODEL), 0.01),
        "g_mix": 1.0 + nrm(ks[6], (DEPTH, D_MODEL), 0.02),
        "w_in": nrm(ks[7], (DEPTH, D_MODEL, N_IN), D_MODEL ** -0.5),
        "w_dec_up": nrm(ks[8], (DEPTH, 2, DECAY_RANK, D_KEY), DECAY_RANK ** -0.5),
        "b_dec": nrm(ks[9], (DEPTH, 2, D_KEY), 0.1),
        "g_head": 1.0 + nrm(ks[10], (DEPTH, HEAD_V), 0.02),
        "w_gla_out": nrm(ks[11], (DEPTH, D_VAL, D_MODEL), D_VAL ** -0.5),
        "w_conv": nrm(ks[12], (DEPTH, CONV_W, D_CONV), CONV_W ** -0.5),
        "w_conv_out": nrm(ks[13], (DEPTH, D_CONV, D_MODEL), D_CONV ** -0.5),
        "w_mix_out": nrm(ks[14], (DEPTH, D_MODEL, D_MODEL), D_MODEL ** -0.5),
        "g_ffn": 1.0 + nrm(ks[15], (DEPTH, D_MODEL), 0.02),
        "w_ffn_in": nrm(ks[16], (DEPTH, D_MODEL, 2 * D_FF), D_MODEL ** -0.5),
        "w_ffn_out": nrm(ks[17], (DEPTH, D_FF, D_MODEL), D_FF ** -0.5),
        "g_final": 1.0 + nrm(ks[18], (D_MODEL,), 0.02),
    }


def reference(x, c, ctx, c_ctx, w_ada, b_ada, g_mix, w_in, w_dec_up, b_dec, g_head, w_gla_out,
              w_conv, w_conv_out, w_mix_out, g_ffn, w_ffn_in, w_ffn_out, g_final):
    rows = x.shape[1] // GRID_W
    bc = ctx.shape[0]
    zeros_state = jnp.zeros((bc, N_HEADS, HEAD_K, HEAD_V), jnp.float32)
    for l in range(DEPTH):
        last = l == DEPTH - 1
        mod_lat = jnp.split(jax.nn.silu(c) @ w_ada[l] + b_ada[l], 6, axis=-1)
        mod_ctx = jnp.split(jax.nn.silu(c_ctx)[None, :] @ w_ada[l] + b_ada[l], 6, axis=-1)
        sh1, sc1, gt1, sh2, sc2, gt2 = mod_lat
        sh1c, sc1c, gt1c, sh2c, sc2c, gt2c = mod_ctx

        pl = project(modulate(rmsnorm(x, g_mix[l]), sh1, sc1), w_in[l], w_dec_up[l], b_dec[l])
        pc = project(modulate(rmsnorm(ctx, g_mix[l]), sh1c, sc1c), w_in[l], w_dec_up[l], b_dec[l])
        o_c, s_cf, s_cb = gla_bidir(pc[0], pc[1], pc[2], pc[4], pc[5], zeros_state, zeros_state)
        o_l, _, _ = gla_bidir(pl[0], pl[1], pl[2], pl[4], pl[5], s_cf, s_cb)
        mix_l = merge_branches(o_l, pl[3], pl[6], pl[7], pl[8], pl[9], pl[10], rows, g_head[l],
                               w_gla_out[l], w_conv[l], w_conv_out[l], w_mix_out[l])
        x = x + gt1[:, None, :] * mix_l
        if not last:
            mix_c = merge_branches(o_c, pc[3], pc[6], pc[7], pc[8], pc[9], pc[10], None, g_head[l],
                                   w_gla_out[l], w_conv[l], w_conv_out[l], w_mix_out[l])
            ctx = ctx + gt1c[:, None, :] * mix_c

        x = x + gt2[:, None, :] * swiglu(modulate(rmsnorm(x, g_ffn[l]), sh2, sc2), w_ffn_in[l], w_ffn_out[l])
        if not last:
            ctx = ctx + gt2c[:, None, :] * swiglu(modulate(rmsnorm(ctx, g_ffn[l]), sh2c, sc2c),
                                                  w_ffn_in[l], w_ffn_out[l])
    return rmsnorm(x, g_final)
```

```cpp
#include <hip/hip_runtime.h>
#include <hip/hip_cooperative_groups.h>
#include <cstdio>
namespace cg = cooperative_groups;

#define SANITIZE 1
#ifndef FUSED
#define FUSED 0
#endif

#define LAS __attribute__((address_space(3)))
typedef unsigned short bf16_t;
typedef short bf16x8 __attribute__((ext_vector_type(8)));
typedef float f32x4 __attribute__((ext_vector_type(4)));
typedef unsigned u32x4 __attribute__((ext_vector_type(4)));
typedef unsigned u32x2 __attribute__((ext_vector_type(2)));

constexpr int DM = 1024, NB = 8, SEQ = 4096, CTXL = 256;
constexpr int ML = NB * SEQ, MC = NB * CTXL, MT = ML + MC;
constexpr int DFF = 2816, NIN = 8224, NINP = 8448, NCH = 68;
constexpr int LDS_BYTES = 131072;
constexpr int NPHASE = 14;

constexpr size_t OFF_WIN = 0;
constexpr size_t OFF_WGLA = OFF_WIN + (size_t)NINP * 1024 * 2;
constexpr size_t OFF_WCONV = OFF_WGLA + 2097152;
constexpr size_t OFF_WMIX = OFF_WCONV + 2097152;
constexpr size_t OFF_WFFI = OFF_WMIX + 2097152;
constexpr size_t OFF_WFFO = OFF_WFFI + (size_t)5632 * 1024 * 2;
constexpr size_t OFF_MOD = OFF_WFFO + (size_t)1024 * 2816 * 2;
constexpr size_t OFF_DEC = OFF_MOD + (size_t)9 * 6144 * 4;
constexpr size_t OFF_DD = OFF_DEC + (size_t)2 * 8 * 4 * NCH * 128 * 4;
constexpr size_t OFF_Q = OFF_DD + (size_t)MT * 32 * 4;
constexpr size_t OFF_K = OFF_Q + (size_t)ML * 512 * 2;
constexpr size_t OFF_V = OFF_K + (size_t)MT * 512 * 2;
constexpr size_t OFF_G = OFF_V + (size_t)MT * 1024 * 2;
constexpr size_t OFF_GA = OFF_G + (size_t)ML * 1024 * 2;
constexpr size_t OFF_U = OFF_GA + (size_t)ML * 1024 * 2;
constexpr size_t OFF_CB = OFF_U + (size_t)ML * 1024 * 2;
constexpr size_t OFF_GB = OFF_CB + (size_t)ML * 1024 * 2;
constexpr size_t WS_NEED = OFF_GB + (size_t)NB * 4 * NCH * 256 * 64 * 2;

struct Params {
    const float *x, *c, *ctx, *c_ctx, *w_ada, *b_ada, *g_mix, *w_in, *w_dec_up, *b_dec, *g_head, *w_gla_out, *w_conv, *w_conv_out,
        *w_mix_out, *g_ffn, *w_ffn_in, *w_ffn_out, *g_final;
    float* out;
    unsigned char* ws;
};

typedef __bf16 bf16v2_t __attribute__((ext_vector_type(2)));
typedef float f32x2_t __attribute__((ext_vector_type(2)));
__device__ __forceinline__ unsigned pk_bf16(float lo, float hi) { const f32x2_t v = {lo, hi}; const bf16v2_t b = __builtin_convertvector(v, bf16v2_t); return __builtin_bit_cast(unsigned, b); }
__device__ __forceinline__ float bf_lo(unsigned w) { return __uint_as_float(w << 16); }
__device__ __forceinline__ float bf_hi(unsigned w) { return __uint_as_float(w & 0xffff0000u); }
__device__ __forceinline__ float bf2f(bf16_t b) { return __uint_as_float(((unsigned)b) << 16); }
__device__ __forceinline__ bf16_t f2bf(float f) { return (bf16_t)(pk_bf16(f, 0.f) & 0xffffu); }
__device__ __forceinline__ float wave_sum(float v) {
#pragma unroll
    for (int o = 32; o > 0; o >>= 1) v += __shfl_xor(v, o);
    return v;
}
__device__ __forceinline__ float sigmoidf_(float v) { return __builtin_amdgcn_rcpf(1.f + __expf(-v)); }

namespace pg8 {
constexpr int BM = 256, BK = 64, HALF = 128, HTB = HALF * BK * 2, NXCD = 8, WGM = 8;
__device__ __forceinline__ int lds_byte(int r, int c) { const int st = (r >> 4) * 2 + (c >> 5), rr = r & 15, cc = c & 31, ob = rr * 64 + cc * 2; return st * 1024 + (ob ^ (((ob >> 9) & 1) << 5)); }
__device__ __forceinline__ void stage_rc(int b, int& R, int& C) { const int st = b / 1024, sb = b % 1024, swz = sb ^ (((sb >> 9) & 1) << 5); R = (st >> 1) * 16 + swz / 64; C = (st & 1) * 32 + (swz % 64) / 2; }
__device__ __forceinline__ int perm32(int rho) { const int n = rho >> 4, i = rho & 15; return 8 * (i >> 2) + 4 * n + (i & 3); }
struct Unit { int pm, pn; };
struct Gemm { const bf16_t* A; const bf16_t* Bt; int M, N, K; };

struct StaticOrder {
    int nM, nN, nwg, G, c;
    __device__ void init(int M, int N, int G_, int c_) { nM = M / BM; nN = N / BM; nwg = nM * nN; G = G_; c = c_; }
    __device__ bool next(int i, Unit& u) const {
        const long L = (long)i * G + c; if (L >= nwg) return false;
        int wgid = (int)L; { const int q = nwg / NXCD, r = nwg % NXCD, xcd = wgid % NXCD, off = wgid / NXCD; wgid = (xcd < r ? xcd * (q + 1) : r * (q + 1) + (xcd - r) * q) + off; }
        const int nig = WGM * nN, gid = wgid / nig, fm = gid * WGM, gsz = (nM - fm) < WGM ? (nM - fm) : WGM;
        u.pm = fm + ((wgid % nig) % gsz); u.pn = (wgid % nig) / gsz; return true;
    }
};
struct InOrder {
    StaticOrder so;
    __device__ void init(int G_, int c_) { so.init(ML, NINP, G_, c_); }
    __device__ bool next(int i, Unit& u) const {
        const long L = (long)i * so.G + so.c;
        if (L < so.nwg) return so.next(i, u);
        const int j = (int)(L - so.nwg); if (j >= 56) return false;
        u.pm = 128 + j / 7; const int cc = j % 7; u.pn = cc < 2 ? 2 + cc : (cc < 6 ? 4 + (cc - 2) : 32); return true;
    }
};

template <class Epi, class Sched>
__device__ __forceinline__ void gemm_phase(LAS unsigned char* lds, const Gemm g, const Sched& S, const Epi& E) {
    const int tid = threadIdx.x, wid = __builtin_amdgcn_readfirstlane(tid >> 6), lane = tid & 63, wr = wid >> 2, wc = wid & 3, fr = lane & 15, fq = lane >> 4;
    const int K = g.K, nt = K / BK;
    unsigned voffA[2], voffB[2];
#pragma unroll
    for (int i = 0; i < 2; ++i) { int R, C; stage_rc(tid * 16 + i * 8192, R, C); const int Rb = Epi::PERM ? ((R & ~31) + perm32(R & 31)) : R;
        voffA[i] = (unsigned)(R * K + C) * 2u; voffB[i] = (unsigned)(Rb * K + C) * 2u; }
    const size_t kstep = (size_t)(BK * 2);
    const size_t hstep = (size_t)HALF * K * 2;
    const size_t tstep = 2 * hstep;
    const unsigned ldsw = (unsigned)wid * 1024u;
    const int aoff = lds_byte(wr * 64 + fr, fq * 8), boff = lds_byte(wc * 32 + fr, fq * 8);
#define PG8_SA(b, h) (((b) * 2 + (h)) * HTB)
#define PG8_SB(b, h) ((4 + (b) * 2 + (h)) * HTB)
#define PG8_STAGE(bufoff, gbase, voff) do { _Pragma("unroll") for (int _i = 0; _i < 2; ++_i) \
        __builtin_amdgcn_global_load_lds((const unsigned*)((const char*)(gbase) + (voff)[_i]), (LAS unsigned*)(lds + (bufoff) + ldsw + _i * 8192), 16, 0, 0); } while (0)
#define PG8_LDA(dst, b, h) do { _Pragma("unroll") for (int m = 0; m < 4; ++m) _Pragma("unroll") for (int k = 0; k < 2; ++k) dst[m][k] = *(const LAS bf16x8*)(lds + PG8_SA(b, h) + aoff + m * 2048 + k * 1024); } while (0)
#define PG8_LDB(dst, b, h) do { _Pragma("unroll") for (int n = 0; n < 2; ++n) _Pragma("unroll") for (int k = 0; k < 2; ++k) dst[n][k] = *(const LAS bf16x8*)(lds + PG8_SB(b, h) + boff + n * 2048 + k * 1024); } while (0)
#define PG8_MMA(ai, bj, At, Bt) do { __builtin_amdgcn_s_setprio(1); _Pragma("unroll") for (int m = 0; m < 4; ++m) _Pragma("unroll") for (int n = 0; n < 2; ++n) _Pragma("unroll") for (int k = 0; k < 2; ++k) \
        acc[ai][bj][m][n] = __builtin_amdgcn_mfma_f32_16x16x32_bf16(Bt[n][k], At[m][k], acc[ai][bj][m][n], 0, 0, 0); __builtin_amdgcn_s_setprio(0); } while (0)
#define PG8_WAIT_V(n) asm volatile("s_waitcnt vmcnt(" #n ")" ::: "memory")
#define PG8_WAIT_L(n) asm volatile("s_waitcnt lgkmcnt(" #n ")" ::: "memory")
#define PG8_BAR __builtin_amdgcn_s_barrier()
#define PG8_SCHED __builtin_amdgcn_sched_barrier(0)
    Unit cur, nxt; int ui = 0;
    if (!S.next(0, cur)) return;
    f32x4 acc[2][2][4][2];
#pragma unroll
    for (int a = 0; a < 2; ++a)
#pragma unroll
        for (int b = 0; b < 2; ++b)
#pragma unroll
            for (int m = 0; m < 4; ++m)
#pragma unroll
                for (int n = 0; n < 2; ++n) acc[a][b][m][n] = (f32x4){0.f, 0.f, 0.f, 0.f};
    bf16x8 At[4][2], B0[2][2], B1[2][2];
    const char* cA = (const char*)g.A + (size_t)cur.pm * tstep; const char* cB = (const char*)g.Bt + (size_t)cur.pn * tstep;
    PG8_STAGE(PG8_SB(0, 0), cB, voffB); PG8_STAGE(PG8_SA(0, 0), cA, voffA); PG8_STAGE(PG8_SB(0, 1), cB + hstep, voffB); PG8_STAGE(PG8_SA(0, 1), cA + hstep, voffA);
    if (wr == 1) PG8_BAR;
    PG8_WAIT_V(4); PG8_BAR;
    PG8_STAGE(PG8_SB(1, 0), cB + kstep, voffB); PG8_STAGE(PG8_SA(1, 0), cA + kstep, voffA); PG8_STAGE(PG8_SB(1, 1), cB + hstep + kstep, voffB);
    PG8_WAIT_V(6); PG8_BAR;
    for (;;) {
        const bool has_next = S.next(ui + 1, nxt);
        const char* nA = has_next ? (const char*)g.A + (size_t)nxt.pm * tstep : cA; const char* nB = has_next ? (const char*)g.Bt + (size_t)nxt.pn * tstep : cB;
        for (int t = 0; t < nt; t += 2) {
            const bool last = (t == nt - 2);
            const char* a1 = cA + (size_t)(t + 1) * kstep;
            const char* a2 = last ? nA : cA + (size_t)(t + 2) * kstep; const char* b2 = last ? nB : cB + (size_t)(t + 2) * kstep;
            const char* a3 = a2 + kstep; const char* b3 = b2 + kstep;
            PG8_LDB(B0, 0, 0); PG8_SCHED; PG8_LDA(At, 0, 0); PG8_STAGE(PG8_SA(1, 1), a1 + hstep, voffA);
            PG8_WAIT_L(8); PG8_BAR; PG8_WAIT_L(0); PG8_MMA(0, 0, At, B0); PG8_BAR; PG8_SCHED;
            PG8_LDB(B1, 0, 1); PG8_STAGE(PG8_SB(0, 0), b2, voffB);
            PG8_BAR; PG8_WAIT_L(0); PG8_MMA(0, 1, At, B1); PG8_BAR;
            PG8_LDA(At, 0, 1); PG8_STAGE(PG8_SA(0, 0), a2, voffA);
            PG8_BAR; PG8_WAIT_L(0); PG8_MMA(1, 0, At, B0); PG8_BAR; PG8_SCHED;
            PG8_STAGE(PG8_SB(0, 1), b2 + hstep, voffB);
            PG8_WAIT_V(6); PG8_BAR; PG8_MMA(1, 1, At, B1); PG8_BAR;
            PG8_LDB(B0, 1, 0); PG8_SCHED; PG8_LDA(At, 1, 0); PG8_STAGE(PG8_SA(0, 1), a2 + hstep, voffA);
            PG8_WAIT_L(8); PG8_BAR; PG8_WAIT_L(0); PG8_MMA(0, 0, At, B0); PG8_BAR; PG8_SCHED;
            PG8_LDB(B1, 1, 1); PG8_STAGE(PG8_SB(1, 0), b3, voffB);
            PG8_BAR; PG8_WAIT_L(0); PG8_MMA(0, 1, At, B1); PG8_BAR;
            PG8_LDA(At, 1, 1); PG8_STAGE(PG8_SA(1, 0), a3, voffA);
            PG8_BAR; PG8_WAIT_L(0); PG8_MMA(1, 0, At, B0); PG8_BAR; PG8_SCHED;
            PG8_STAGE(PG8_SB(1, 1), b3 + hstep, voffB);
            PG8_WAIT_V(6); PG8_BAR; PG8_MMA(1, 1, At, B1); PG8_BAR;
        }
        E(acc, cur, wr, wc, fr, fq);
        if (!has_next) break;
#pragma unroll
        for (int a = 0; a < 2; ++a)
#pragma unroll
            for (int b = 0; b < 2; ++b)
#pragma unroll
                for (int m = 0; m < 4; ++m)
#pragma unroll
                    for (int n = 0; n < 2; ++n) acc[a][b][m][n] = (f32x4){0.f, 0.f, 0.f, 0.f};
        cur = nxt; cA = nA; cB = nB; ++ui;
    }
    PG8_WAIT_V(0);
    if (wr == 0) PG8_BAR;
    PG8_BAR;
#undef PG8_SA
#undef PG8_SB
#undef PG8_STAGE
#undef PG8_LDA
#undef PG8_LDB
#undef PG8_MMA
#undef PG8_WAIT_V
#undef PG8_WAIT_L
#undef PG8_BAR
#undef PG8_SCHED
}
}
using pg8::Unit;

struct EpiInProj {
    static constexpr bool PERM = true;
    bf16_t *q, *k, *v, *g, *cb, *u, *ga, *gb; float* dd;
    __device__ __forceinline__ void operator()(const f32x4 (&acc)[2][2][4][2], const Unit& un, int wr, int wc, int fr, int fq) const {
        const int pn = un.pn; const size_t row0 = (size_t)un.pm * 256 + wr * 64 + fr;
        if (pn < 16 || (pn >= 24 && pn < 32)) {
            bf16_t* base; int ldc, colt, act;
            if (pn < 2) { base = q; ldc = 512; colt = pn * 256; act = 0; }
            else if (pn < 4) { base = k; ldc = 512; colt = (pn - 2) * 256; act = 0; }
            else if (pn < 8) { base = v; ldc = 1024; colt = (pn - 4) * 256; act = 0; }
            else if (pn < 12) { base = g; ldc = 1024; colt = (pn - 8) * 256; act = 1; }
            else if (pn < 16) { base = cb; ldc = 1024; colt = (pn - 12) * 256; act = 0; }
            else if (pn < 28) { base = ga; ldc = 1024; colt = (pn - 24) * 256; act = 2; }
            else { base = gb; ldc = 1024; colt = (pn - 28) * 256; act = 2; }
            const int col0 = colt + wc * 32 + 8 * fq;
#pragma unroll
            for (int ai = 0; ai < 2; ++ai)
#pragma unroll
                for (int m = 0; m < 4; ++m) { bf16_t* rowp = base + (row0 + ai * 128 + m * 16) * ldc + col0;
#pragma unroll
                    for (int bj = 0; bj < 2; ++bj) { f32x4 v0 = acc[ai][bj][m][0], v1 = acc[ai][bj][m][1];
                        if (act) {
#pragma unroll
                            for (int j = 0; j < 4; ++j) { const float s0 = sigmoidf_(v0[j]), s1 = sigmoidf_(v1[j]); v0[j] = act == 1 ? v0[j] * s0 : s0; v1[j] = act == 1 ? v1[j] * s1 : s1; } }
                        u32x4 w; w.x = pk_bf16(v0[0], v0[1]); w.y = pk_bf16(v0[2], v0[3]); w.z = pk_bf16(v1[0], v1[1]); w.w = pk_bf16(v1[2], v1[3]);
                        *(u32x4*)(rowp + bj * 128) = w; } }
        } else if (pn < 24) {
            const int col0 = (pn - 16) * 128 + wc * 32 + 8 * fq;
#pragma unroll
            for (int ai = 0; ai < 2; ++ai)
#pragma unroll
                for (int m = 0; m < 4; ++m) { const f32x4 v0 = acc[ai][0][m][0] * acc[ai][1][m][0], v1 = acc[ai][0][m][1] * acc[ai][1][m][1];
                    u32x4 w; w.x = pk_bf16(v0[0], v0[1]); w.y = pk_bf16(v0[2], v0[3]); w.z = pk_bf16(v1[0], v1[1]); w.w = pk_bf16(v1[2], v1[3]);
                    *(u32x4*)(u + (row0 + ai * 128 + m * 16) * 1024 + col0) = w; }
        } else {
            if (wc == 0) {
#pragma unroll
                for (int ai = 0; ai < 2; ++ai)
#pragma unroll
                    for (int m = 0; m < 4; ++m) { float* rp = dd + (row0 + ai * 128 + m * 16) * 32 + 8 * fq;
                        *(f32x4*)rp = acc[ai][0][m][0]; *(f32x4*)(rp + 4) = acc[ai][0][m][1]; }
            }
        }
    }
};
template <int MODE> struct EpiGate {
    static constexpr bool PERM = true;
    bf16_t* T; const bf16_t* sg;
    __device__ __forceinline__ void operator()(const f32x4 (&acc)[2][2][4][2], const Unit& un, int wr, int wc, int fr, int fq) const {
        const size_t row0 = (size_t)un.pm * 256 + wr * 64 + fr; const int col0 = un.pn * 256 + wc * 32 + 8 * fq;
#pragma unroll
        for (int ai = 0; ai < 2; ++ai)
#pragma unroll
            for (int m = 0; m < 4; ++m)
#pragma unroll
                for (int bj = 0; bj < 2; ++bj) { const size_t off = (row0 + ai * 128 + m * 16) * 1024 + col0 + bj * 128;
                    const u32x4 s = *(const u32x4*)(sg + off); const f32x4 a0 = acc[ai][bj][m][0], a1 = acc[ai][bj][m][1];
                    float o[8] = {a0[0] * bf_lo(s.x), a0[1] * bf_hi(s.x), a0[2] * bf_lo(s.y), a0[3] * bf_hi(s.y), a1[0] * bf_lo(s.z), a1[1] * bf_hi(s.z), a1[2] * bf_lo(s.w), a1[3] * bf_hi(s.w)};
                    if (MODE == 1) { const u32x4 t = *(const u32x4*)(T + off);
                        o[0] += bf_lo(t.x); o[1] += bf_hi(t.x); o[2] += bf_lo(t.y); o[3] += bf_hi(t.y); o[4] += bf_lo(t.z); o[5] += bf_hi(t.z); o[6] += bf_lo(t.w); o[7] += bf_hi(t.w); }
                    u32x4 w; w.x = pk_bf16(o[0], o[1]); w.y = pk_bf16(o[2], o[3]); w.z = pk_bf16(o[4], o[5]); w.w = pk_bf16(o[6], o[7]);
                    *(u32x4*)(T + off) = w; }
    }
};
struct EpiRes {
    static constexpr bool PERM = true;
    const float* xin; float* out; const float* gate;
    __device__ __forceinline__ void operator()(const f32x4 (&acc)[2][2][4][2], const Unit& un, int wr, int wc, int fr, int fq) const {
        const size_t row0 = (size_t)un.pm * 256 + wr * 64 + fr; const int col0 = un.pn * 256 + wc * 32 + 8 * fq;
        const float* gp = gate + (size_t)(un.pm >> 4) * 6144 + col0;
        f32x4 gv[2][2];
#pragma unroll
        for (int bj = 0; bj < 2; ++bj)
#pragma unroll
            for (int n = 0; n < 2; ++n) gv[bj][n] = *(const f32x4*)(gp + bj * 128 + 4 * n);
#pragma unroll
        for (int ai = 0; ai < 2; ++ai)
#pragma unroll
            for (int m = 0; m < 4; ++m)
#pragma unroll
                for (int bj = 0; bj < 2; ++bj)
#pragma unroll
                    for (int n = 0; n < 2; ++n) { const size_t off = (row0 + ai * 128 + m * 16) * 1024 + col0 + bj * 128 + 4 * n;
                        const f32x4 xv = *(const f32x4*)(xin + off); *(f32x4*)(out + off) = xv + gv[bj][n] * acc[ai][bj][m][n]; }
    }
};
struct EpiFfnIn {
    static constexpr bool PERM = true;
    bf16_t* s;
    __device__ __forceinline__ void operator()(const f32x4 (&acc)[2][2][4][2], const Unit& un, int wr, int wc, int fr, int fq) const {
        const size_t row0 = (size_t)un.pm * 256 + wr * 64 + fr; const int col0 = un.pn * 128 + wc * 32 + 8 * fq;
#pragma unroll
        for (int ai = 0; ai < 2; ++ai)
#pragma unroll
            for (int m = 0; m < 4; ++m) { float o[8];
#pragma unroll
                for (int n = 0; n < 2; ++n)
#pragma unroll
                    for (int j = 0; j < 4; ++j) { const float a = acc[ai][0][m][n][j], b = acc[ai][1][m][n][j]; o[4 * n + j] = a * sigmoidf_(a) * b; }
                u32x4 w; w.x = pk_bf16(o[0], o[1]); w.y = pk_bf16(o[2], o[3]); w.z = pk_bf16(o[4], o[5]); w.w = pk_bf16(o[6], o[7]);
                *(u32x4*)(s + (row0 + ai * 128 + m * 16) * DFF + col0) = w; }
    }
};

__device__ __forceinline__ void adaln_item(const Params& p, LAS unsigned char* lds, int it) {
    const int tid = threadIdx.x, lane = tid & 63, wid = tid >> 6;
    LAS float* sl = (LAS float*)lds;
    LAS float* red = sl + 9 * 1024;
    for (int i = tid; i < 9 * 1024; i += 512) { const int r = i >> 10, k = i & 1023; const float cv = r < 8 ? p.c[r * 1024 + k] : p.c_ctx[k]; sl[i] = cv / (1.f + __expf(-cv)); }
    __syncthreads();
    const int c0 = 32 * it, kg = tid >> 3, cq = tid & 7;
    float acc[9][4];
#pragma unroll
    for (int r = 0; r < 9; ++r)
#pragma unroll
        for (int j = 0; j < 4; ++j) acc[r][j] = 0.f;
    for (int kk = 0; kk < 16; ++kk) { const int k = kg * 16 + kk; const f32x4 w = *(const f32x4*)(p.w_ada + (size_t)k * 6144 + c0 + 4 * cq);
#pragma unroll
        for (int r = 0; r < 9; ++r) { const float s = sl[r * 1024 + k];
#pragma unroll
            for (int j = 0; j < 4; ++j) acc[r][j] += s * w[j]; } }
#pragma unroll
    for (int r = 0; r < 9; ++r)
#pragma unroll
        for (int j = 0; j < 4; ++j) { float v = acc[r][j]; v += __shfl_xor(v, 8); v += __shfl_xor(v, 16); v += __shfl_xor(v, 32); acc[r][j] = v; }
    if ((lane >> 3) == 0) {
#pragma unroll
        for (int r = 0; r < 9; ++r)
#pragma unroll
            for (int j = 0; j < 4; ++j) red[(wid * 9 + r) * 32 + 4 * cq + j] = acc[r][j]; }
    __syncthreads();
    if (tid < 288) { const int r = tid >> 5, cc = tid & 31; float s = 0.f;
#pragma unroll
        for (int w = 0; w < 8; ++w) s += red[(w * 9 + r) * 32 + cc];
        ((float*)(p.ws + OFF_MOD))[r * 6144 + c0 + cc] = s + p.b_ada[c0 + cc]; }
}
__device__ __forceinline__ void wconv_tile(const Params& p, LAS unsigned char* lds, int j) {
    const int tid = threadIdx.x;
    const float* src; bf16_t* dst; int sld, dld, nt, kt, srccol, nvalid = 64;
    if (j < 2112) { nt = j >> 4; kt = j & 15; src = p.w_in; sld = NIN; dst = (bf16_t*)(p.ws + OFF_WIN); dld = 1024;
        const int n0 = nt * 64;
        if (n0 < 3072) srccol = n0;
        else if (n0 < 4096) srccol = 3104 + (n0 - 3072);
        else if (n0 < 6144) { const int i = n0 - 4096, pt = i >> 8, w = i & 255; srccol = w < 128 ? 4128 + 128 * pt + w : 5152 + 128 * pt + (w - 128); }
        else if (n0 < 7168) srccol = 6176 + (n0 - 6144);
        else if (n0 < 8192) srccol = 7200 + (n0 - 7168);
        else if (n0 == 8192) { srccol = 3072; nvalid = 32; }
        else { srccol = 0; nvalid = 0; }
    } else if (j < 2880) { const int jj = j - 2112, mi = jj >> 8, r = jj & 255; nt = r >> 4; kt = r & 15; sld = 1024; dld = 1024; srccol = nt * 64;
        src = mi == 0 ? p.w_gla_out : (mi == 1 ? p.w_conv_out : p.w_mix_out); dst = (bf16_t*)(p.ws + (mi == 0 ? OFF_WGLA : (mi == 1 ? OFF_WCONV : OFF_WMIX)));
    } else if (j < 4288) { const int jj = j - 2880; nt = jj >> 4; kt = jj & 15; src = p.w_ffn_in; sld = 2 * DFF; dst = (bf16_t*)(p.ws + OFF_WFFI); dld = 1024;
        const int n0 = nt * 64, pt = n0 >> 8, w = n0 & 255; srccol = w < 128 ? 128 * pt + w : DFF + 128 * pt + (w - 128);
    } else { const int jj = j - 4288; nt = jj / 44; kt = jj % 44; src = p.w_ffn_out; sld = 1024; dst = (bf16_t*)(p.ws + OFF_WFFO); dld = DFF; srccol = nt * 64; }
    const int n0 = nt * 64, k0 = kt * 64;
    LAS float* tile = (LAS float*)lds;
    { const int jc = tid & 63, kk0 = tid >> 6;
#pragma unroll
        for (int i = 0; i < 8; ++i) { const int kk = kk0 + 8 * i; tile[kk * 65 + jc] = jc < nvalid ? src[(size_t)(k0 + kk) * sld + srccol + jc] : 0.f; } }
    __syncthreads();
    { const int jr = tid >> 3, kg = tid & 7; float v[8];
#pragma unroll
        for (int e = 0; e < 8; ++e) v[e] = tile[(8 * kg + e) * 65 + jr];
        u32x4 w; w.x = pk_bf16(v[0], v[1]); w.y = pk_bf16(v[2], v[3]); w.z = pk_bf16(v[4], v[5]); w.w = pk_bf16(v[6], v[7]);
        *(u32x4*)(dst + (size_t)(n0 + jr) * dld + k0 + 8 * kg) = w; }
}
__device__ void phase_prep(const Params& p, LAS unsigned char* lds) {
    constexpr int NADA = 192, NTILES = 2112 + 768 + 1408 + 704;
    for (int it = blockIdx.x; it < NADA + NTILES; it += gridDim.x) {
        if (it < NADA) adaln_item(p, lds, it); else wconv_tile(p, lds, it - NADA);
        __syncthreads();
    }
}

__device__ __forceinline__ void norm_mod_rows(const float* src0, const float* src1, int nrows0, int nrows, bf16_t* dst, const float* gw, const float* mod, int sh_off, int sc_off) {
    const int lane = threadIdx.x & 63, wid = threadIdx.x >> 6;
    for (int row = blockIdx.x * 8 + wid; row < nrows; row += gridDim.x * 8) {
        const float* s = row < nrows0 ? src0 + (size_t)row * 1024 : src1 + (size_t)(row - nrows0) * 1024;
        const int mr = row < nrows0 ? row / SEQ : 8;
        f32x4 v[4];
        v[0] = *(const f32x4*)(s + 8 * lane); v[1] = *(const f32x4*)(s + 8 * lane + 4); v[2] = *(const f32x4*)(s + 512 + 8 * lane); v[3] = *(const f32x4*)(s + 512 + 8 * lane + 4);
        float ss = 0.f;
#pragma unroll
        for (int i = 0; i < 4; ++i)
#pragma unroll
            for (int j = 0; j < 4; ++j) ss += v[i][j] * v[i][j];
        ss = wave_sum(ss);
        const float rs = rsqrtf(ss * (1.f / 1024.f) + 1e-6f);
        const float* mp = mod + (size_t)mr * 6144;
#pragma unroll
        for (int hh = 0; hh < 2; ++hh) { const int c = hh * 512 + 8 * lane; float o[8];
#pragma unroll
            for (int q = 0; q < 2; ++q) { const f32x4 gg = *(const f32x4*)(gw + c + 4 * q), sc = *(const f32x4*)(mp + sc_off + c + 4 * q), sh = *(const f32x4*)(mp + sh_off + c + 4 * q);
#pragma unroll
                for (int j = 0; j < 4; ++j) o[4 * q + j] = (v[2 * hh + q][j] * rs * gg[j]) * (1.f + sc[j]) + sh[j]; }
            u32x4 w; w.x = pk_bf16(o[0], o[1]); w.y = pk_bf16(o[2], o[3]); w.z = pk_bf16(o[4], o[5]); w.w = pk_bf16(o[6], o[7]);
            *(u32x4*)(dst + (size_t)row * 1024 + c) = w; }
    }
}
__device__ void phase_final(const Params& p) {
    const int lane = threadIdx.x & 63, wid = threadIdx.x >> 6;
    for (int row = blockIdx.x * 8 + wid; row < ML; row += gridDim.x * 8) {
        float* s = p.out + (size_t)row * 1024;
        f32x4 v[4];
        v[0] = *(const f32x4*)(s + 8 * lane); v[1] = *(const f32x4*)(s + 8 * lane + 4); v[2] = *(const f32x4*)(s + 512 + 8 * lane); v[3] = *(const f32x4*)(s + 512 + 8 * lane + 4);
        float ss = 0.f;
#pragma unroll
        for (int i = 0; i < 4; ++i)
#pragma unroll
            for (int j = 0; j < 4; ++j) ss += v[i][j] * v[i][j];
        ss = wave_sum(ss);
        const float rs = rsqrtf(ss * (1.f / 1024.f) + 1e-6f);
#pragma unroll
        for (int i = 0; i < 4; ++i) { const int c = (i >> 1) * 512 + 8 * lane + 4 * (i & 1); const f32x4 gg = *(const f32x4*)(p.g_final + c); f32x4 o = v[i] * rs * gg;
#ifdef SANITIZE
#pragma unroll
            for (int j = 0; j < 4; ++j) o[j] = (__builtin_fabsf(o[j]) < 1e30f) ? o[j] : 0.f;
#endif
            *(f32x4*)(s + c) = o; }
    }
}

__device__ void phase_conv(const Params& p) {
    bf16_t* cb = (bf16_t*)(p.ws + OFF_CB); const bf16_t* u = (const bf16_t*)(p.ws + OFF_U);
    const int total = ML * 128;
    for (int i = blockIdx.x * 512 + threadIdx.x; i < total; i += gridDim.x * 512) {
        const int t = i >> 7, c = (i & 127) * 8, tl = t & 63; const size_t off = (size_t)t * 1024 + c;
        const u32x4 z = {0u, 0u, 0u, 0u};
        const u32x4 u0 = *(const u32x4*)(u + off), um = tl > 0 ? *(const u32x4*)(u + off - 1024) : z, up = tl < 63 ? *(const u32x4*)(u + off + 1024) : z, cv = *(const u32x4*)(cb + off);
        float w0[8], w1[8], w2[8];
#pragma unroll
        for (int q = 0; q < 2; ++q) { const f32x4 a = *(const f32x4*)(p.w_conv + c + 4 * q), b = *(const f32x4*)(p.w_conv + 1024 + c + 4 * q), d = *(const f32x4*)(p.w_conv + 2048 + c + 4 * q);
#pragma unroll
            for (int j = 0; j < 4; ++j) { w0[4 * q + j] = a[j]; w1[4 * q + j] = b[j]; w2[4 * q + j] = d[j]; } }
        float o[8];
#pragma unroll
        for (int e = 0; e < 4; ++e) {
            const unsigned a = um[e], b = u0[e], d = up[e], cc = cv[e];
            o[2 * e] = bf_lo(cc) * (bf_lo(a) * w0[2 * e] + bf_lo(b) * w1[2 * e] + bf_lo(d) * w2[2 * e]);
            o[2 * e + 1] = bf_hi(cc) * (bf_hi(a) * w0[2 * e + 1] + bf_hi(b) * w1[2 * e + 1] + bf_hi(d) * w2[2 * e + 1]);
        }
        u32x4 w; w.x = pk_bf16(o[0], o[1]); w.y = pk_bf16(o[2], o[3]); w.z = pk_bf16(o[4], o[5]); w.w = pk_bf16(o[6], o[7]);
        *(u32x4*)(cb + off) = w;
    }
}

constexpr int A_DD = 0, A_QR = 8192, A_KR = 25600, A_HT = 43008, A_QD = 45056, A_KD = 79872, A_P = 114688, A_VT = 8192;
constexpr int A_RS = 272;
constexpr int A_PS = 144;
constexpr float QSCALE = 0.08838834764831845f;

template <int DIR>
__device__ __forceinline__ void gla_pass2(LAS unsigned char* lds, const float (&la)[32], int ch, int half, bool lat, float bmid, float blast, float start, bf16_t* q2g  , bf16_t* k2g  ) {
    float b = start; unsigned kp[16];
#pragma unroll
    for (int s = 0; s < 32; ++s) {
        const int i = DIR == 0 ? s : 31 - s; const int t = half * 32 + i;
        b += la[i];
        const float kk = bf2f(*(const LAS bf16_t*)(lds + A_KR + t * A_RS + ch * 2));
        const float k2 = kk * __expf(blast - b);
        const unsigned kb = pk_bf16(k2, 0.f) & 0xffffu;
        if ((i & 1) == 0) kp[i >> 1] = (DIR == 0) ? kb : (kp[i >> 1] | kb); else kp[i >> 1] = (DIR == 0) ? (kp[i >> 1] | (kb << 16)) : (kb << 16);
        if (lat) {
            const float qq = bf2f(*(const LAS bf16_t*)(lds + A_QR + t * A_RS + ch * 2)) * QSCALE;
            *(LAS bf16_t*)(lds + A_QD + DIR * 17408 + t * A_RS + ch * 2) = f2bf(qq * __expf(b - bmid));
            *(LAS bf16_t*)(lds + A_KD + DIR * 17408 + t * A_RS + ch * 2) = f2bf(kk * __expf(bmid - b));
            q2g[(size_t)t * 512] = f2bf(qq * __expf(b));
        }
    }
#pragma unroll
    for (int g4 = 0; g4 < 4; ++g4) { u32x4 w; w.x = kp[4 * g4]; w.y = kp[4 * g4 + 1]; w.z = kp[4 * g4 + 2]; w.w = kp[4 * g4 + 3]; *(u32x4*)(k2g + 8 * g4) = w; }
}

__device__ void phase_gla_a(const Params& p, LAS unsigned char* lds) {
    const int tid = threadIdx.x, lane = tid & 63, wid = tid >> 6, fr = lane & 15, fq = lane >> 4;
    const float* dd = (const float*)(p.ws + OFF_DD);
    const bf16_t* qb = (const bf16_t*)(p.ws + OFF_Q); const bf16_t* kb = (const bf16_t*)(p.ws + OFF_K);
    bf16_t* vb = (bf16_t*)(p.ws + OFF_V);
    bf16_t* Q2 = (bf16_t*)(p.ws + OFF_CB); bf16_t* K2T = (bf16_t*)p.out; bf16_t* VT = (bf16_t*)(p.ws + OFF_GB); float* dec = (float*)(p.ws + OFF_DEC);
    for (int it = blockIdx.x; it < 2048 + 128; it += gridDim.x) {
        const bool lat = it < 2048;
        int b, c, h; size_t row0; int cidx;
        if (lat) { b = it >> 8; c = (it & 255) >> 2; h = it & 3; row0 = (size_t)b * SEQ + c * 64; cidx = c; }
        else { const int j = it - 2048; b = j >> 4; c = (j & 15) >> 2; h = j & 3; row0 = (size_t)ML + b * CTXL + c * 64; cidx = 64 + c; }
        { const int r = tid >> 3, c4 = tid & 7; *(LAS f32x4*)(lds + A_DD + r * 128 + c4 * 16) = *(const f32x4*)(dd + (row0 + r) * 32 + 4 * c4); }
#pragma unroll
        for (int i = 0; i < 2; ++i) { const int pc = tid + 512 * i, r = pc >> 4, cp = pc & 15;
            *(LAS u32x4*)(lds + A_KR + r * A_RS + cp * 16) = *(const u32x4*)(kb + (row0 + r) * 512 + h * 128 + 8 * cp);
            if (lat) *(LAS u32x4*)(lds + A_QR + r * A_RS + cp * 16) = *(const u32x4*)(qb + (row0 + r) * 512 + h * 128 + 8 * cp); }
        const int ch = tid & 127, dir = (tid >> 7) & 1, half = tid >> 8;
        float w[16];
#pragma unroll
        for (int r = 0; r < 16; ++r) w[r] = p.w_dec_up[(size_t)(dir * 16 + r) * 512 + h * 128 + ch];
        const float bias = p.b_dec[dir * 512 + h * 128 + ch];
        __syncthreads();
        float la[32]; float tot = 0.f;
#pragma unroll
        for (int i = 0; i < 32; ++i) { const int t = half * 32 + i; const LAS f32x4* dp = (const LAS f32x4*)(lds + A_DD + t * 128 + dir * 64);
            float z = bias;
#pragma unroll
            for (int q4 = 0; q4 < 4; ++q4) { const f32x4 d = dp[q4];
#pragma unroll
                for (int j = 0; j < 4; ++j) z += d[j] * w[4 * q4 + j]; }
            const float l = (fminf(z, 0.f) - __logf(1.f + __expf(-fabsf(z)))) * (1.f / 16.f);
            la[i] = l; tot += l; }
        ((LAS float*)(lds + A_HT))[(dir * 2 + half) * 128 + ch] = tot;
        __syncthreads();
        { const float h0 = ((LAS float*)(lds + A_HT))[(dir * 2 + 0) * 128 + ch], h1 = ((LAS float*)(lds + A_HT))[(dir * 2 + 1) * 128 + ch];
            const float blast = h0 + h1;
            bf16_t* q2g = Q2 + ((size_t)dir * ML + (lat ? row0 : 0)) * 512 + h * 128 + ch;
            bf16_t* k2g = K2T + ((((size_t)dir * 8 + b) * 4 + h) * NCH + cidx) * 8192 + ch * 64 + half * 32;
            if (dir == 0) gla_pass2<0>(lds, la, ch, half, lat, h0, blast, half ? h0 : 0.f, q2g, k2g);
            else gla_pass2<1>(lds, la, ch, half, lat, h1, blast, half ? 0.f : h1, q2g, k2g);
            if (half == 0) dec[((((size_t)dir * 8 + b) * 4 + h) * NCH + cidx) * 128 + ch] = __expf(blast); }
        __syncthreads();
#pragma unroll
        for (int i = 0; i < 4; ++i) { const int t = lane, cp = wid + 8 * i;
            const u32x4 vv = *(const u32x4*)(vb + (row0 + t) * 1024 + h * 256 + 8 * cp);
#pragma unroll
            for (int e = 0; e < 4; ++e) { *(LAS bf16_t*)(lds + A_VT + (8 * cp + 2 * e) * A_PS + t * 2) = (bf16_t)(vv[e] & 0xffffu); *(LAS bf16_t*)(lds + A_VT + (8 * cp + 2 * e + 1) * A_PS + t * 2) = (bf16_t)(vv[e] >> 16); } }
        if (lat) {
            const int rt = wid >> 1, ct0 = (wid & 1) * 2;
            f32x4 ps[2] = {{0.f, 0.f, 0.f, 0.f}, {0.f, 0.f, 0.f, 0.f}};
#pragma unroll
            for (int d = 0; d < 2; ++d)
#pragma unroll
                for (int cc = 0; cc < 2; ++cc) { const int ct = ct0 + cc; f32x4 a = {0.f, 0.f, 0.f, 0.f};
#pragma unroll
                    for (int ks = 0; ks < 4; ++ks) { const bf16x8 af = *(const LAS bf16x8*)(lds + A_QD + d * 17408 + (16 * rt + fr) * A_RS + (32 * ks + 8 * fq) * 2), bfr = *(const LAS bf16x8*)(lds + A_KD + d * 17408 + (16 * ct + fr) * A_RS + (32 * ks + 8 * fq) * 2);
                        a = __builtin_amdgcn_mfma_f32_16x16x32_bf16(af, bfr, a, 0, 0, 0); }
#pragma unroll
                    for (int r = 0; r < 4; ++r) { const int i = 16 * rt + 4 * fq + r, j = 16 * ct + fr; const bool keep = d == 0 ? (i >= j) : (j >= i); ps[cc][r] += keep ? a[r] : 0.f; } }
#pragma unroll
            for (int cc = 0; cc < 2; ++cc)
#pragma unroll
                for (int r = 0; r < 4; ++r) *(LAS bf16_t*)(lds + A_P + (16 * rt + 4 * fq + r) * A_PS + (16 * (ct0 + cc) + fr) * 2) = f2bf(ps[cc][r]);
        }
        __syncthreads();
        { bf16_t* vtg = VT + (((size_t)b * 4 + h) * NCH + cidx) * 16384;
#pragma unroll
            for (int i = 0; i < 4; ++i) { const int pc = tid + 512 * i, vc = pc >> 3, tp = pc & 7; *(u32x4*)(vtg + vc * 64 + tp * 8) = *(const LAS u32x4*)(lds + A_VT + vc * A_PS + tp * 16); } }
        if (lat) {
#pragma unroll
            for (int vv = 0; vv < 2; ++vv) { const int vct = 2 * wid + vv;
#pragma unroll
                for (int rt = 0; rt < 4; ++rt) { f32x4 a = {0.f, 0.f, 0.f, 0.f};
#pragma unroll
                    for (int ks = 0; ks < 2; ++ks) { const bf16x8 af = *(const LAS bf16x8*)(lds + A_VT + (16 * vct + fr) * A_PS + (32 * ks + 8 * fq) * 2), bfr = *(const LAS bf16x8*)(lds + A_P + (16 * rt + fr) * A_PS + (32 * ks + 8 * fq) * 2);
                        a = __builtin_amdgcn_mfma_f32_16x16x32_bf16(af, bfr, a, 0, 0, 0); }
                    u32x2 w; w.x = pk_bf16(a[0], a[1]); w.y = pk_bf16(a[2], a[3]);
                    *(u32x2*)(vb + (row0 + 16 * rt + fr) * 1024 + h * 256 + 16 * vct + 4 * fq) = w; } }
        }
        __syncthreads();
    }
}

constexpr int B_ST = 0, B_STS = 272;
__device__ void phase_gla_b(const Params& p, LAS unsigned char* lds) {
    const int tid = threadIdx.x, lane = tid & 63, wid = __builtin_amdgcn_readfirstlane(tid >> 6), fr = lane & 15, fq = lane >> 4;
    const bf16_t* Q2 = (const bf16_t*)(p.ws + OFF_CB); const bf16_t* K2T = (const bf16_t*)p.out; const bf16_t* VT = (const bf16_t*)(p.ws + OFF_GB); const float* dec = (const float*)(p.ws + OFF_DEC);
    bf16_t* of = (bf16_t*)(p.ws + OFF_Q); bf16_t* vb = (bf16_t*)(p.ws + OFF_V);
    const int kt0 = (wid >> 1) * 2, ct0 = (wid & 1) * 2, rt = wid & 3, vct0 = (wid >> 2) * 2;
    for (int it = blockIdx.x; it < 256; it += gridDim.x) {
        const int grp = (it & 7) * 8 + ((it >> 3) >> 2), vs = (it >> 3) & 3, b = grp >> 3, h = (grp >> 1) & 3, dir = grp & 1;
        const bf16_t* k2b = K2T + ((((size_t)dir * 8 + b) * 4 + h) * NCH) * 8192;
        const bf16_t* vtb = VT + (((size_t)b * 4 + h) * NCH) * 16384 + (size_t)vs * 64 * 64;
        const float* dcb = dec + ((((size_t)dir * 8 + b) * 4 + h) * NCH) * 128;
        const bf16_t* q2b = Q2 + ((size_t)dir * ML + (size_t)b * SEQ) * 512 + h * 128;
        f32x4 S[2][2];
#pragma unroll
        for (int i = 0; i < 2; ++i)
#pragma unroll
            for (int j = 0; j < 2; ++j) S[i][j] = (f32x4){0.f, 0.f, 0.f, 0.f};
        bf16x8 kf[2][2], vf[2][2], nkf[2][2], nvf[2][2], qf[4]; f32x4 df[2], ndf[2];
#define GB_CIDX(n) (dir == 0 ? ((n) < 4 ? 64 + (n) : (n) - 4) : ((n) < 4 ? 67 - (n) : 67 - (n)))
#define GB_LOAD(KF, VF, DF, ci) do { _Pragma("unroll") for (int i = 0; i < 2; ++i) { _Pragma("unroll") for (int ks = 0; ks < 2; ++ks) { \
            KF[i][ks] = *(const bf16x8*)(k2b + (size_t)(ci) * 8192 + (16 * (kt0 + i) + fr) * 64 + 32 * ks + 8 * fq); \
            VF[i][ks] = *(const bf16x8*)(vtb + (size_t)(ci) * 16384 + (16 * (ct0 + i) + fr) * 64 + 32 * ks + 8 * fq); } \
            DF[i] = *(const f32x4*)(dcb + (size_t)(ci) * 128 + 16 * (kt0 + i) + 4 * fq); } } while (0)
        { const int c0i = dir == 0 ? 64 : 67; GB_LOAD(kf, vf, df, c0i); }
#pragma unroll 1
        for (int n = 0; n < NCH; ++n) {
            const bool lat = n >= 4; const int cl = dir == 0 ? n - 4 : 67 - n;
            if (lat) {
#pragma unroll
                for (int ks = 0; ks < 4; ++ks) qf[ks] = *(const bf16x8*)(q2b + (size_t)(cl * 64 + 16 * rt + fr) * 512 + 32 * ks + 8 * fq); }
            { const int nn = n + 1 < NCH ? n + 1 : n; const int ci = dir == 0 ? (nn < 4 ? 64 + nn : nn - 4) : 67 - nn; GB_LOAD(nkf, nvf, ndf, ci); }
            LAS unsigned char* st = lds + B_ST + (n & 1) * 17408;
            if (lat) {
#pragma unroll
                for (int i = 0; i < 2; ++i)
#pragma unroll
                    for (int j = 0; j < 2; ++j) { u32x2 w; w.x = pk_bf16(S[i][j][0], S[i][j][1]); w.y = pk_bf16(S[i][j][2], S[i][j][3]);
                        *(LAS u32x2*)(st + (16 * (ct0 + j) + fr) * B_STS + (16 * (kt0 + i) + 4 * fq) * 2) = w; } }
            __syncthreads();
#pragma unroll
            for (int i = 0; i < 2; ++i)
#pragma unroll
                for (int j = 0; j < 2; ++j) { S[i][j] = S[i][j] * df[i];
#pragma unroll
                    for (int ks = 0; ks < 2; ++ks) S[i][j] = __builtin_amdgcn_mfma_f32_16x16x32_bf16(kf[i][ks], vf[j][ks], S[i][j], 0, 0, 0); }
            if (lat) {
#pragma unroll
                for (int jj = 0; jj < 2; ++jj) { f32x4 a = {0.f, 0.f, 0.f, 0.f};
#pragma unroll
                    for (int ks = 0; ks < 4; ++ks) { const bf16x8 af = *(const LAS bf16x8*)(st + (16 * (vct0 + jj) + fr) * B_STS + (32 * ks + 8 * fq) * 2);
                        a = __builtin_amdgcn_mfma_f32_16x16x32_bf16(af, qf[ks], a, 0, 0, 0); }
                    const size_t off = ((size_t)b * SEQ + cl * 64 + 16 * rt + fr) * 1024 + h * 256 + vs * 64 + 16 * (vct0 + jj) + 4 * fq;
                    if (dir == 0) { u32x2 w; w.x = pk_bf16(a[0], a[1]); w.y = pk_bf16(a[2], a[3]); *(u32x2*)(of + off) = w; }
                    else { const u32x2 o = *(const u32x2*)(vb + off); u32x2 w; w.x = pk_bf16(a[0] + bf_lo(o.x), a[1] + bf_hi(o.x)); w.y = pk_bf16(a[2] + bf_lo(o.y), a[3] + bf_hi(o.y)); *(u32x2*)(vb + off) = w; } }
            }
#pragma unroll
            for (int i = 0; i < 2; ++i) { df[i] = ndf[i];
#pragma unroll
                for (int ks = 0; ks < 2; ++ks) { kf[i][ks] = nkf[i][ks]; vf[i][ks] = nvf[i][ks]; } }
        }
        __syncthreads();
#undef GB_LOAD
#undef GB_CIDX
    }
}

__device__ void phase_agla(const Params& p) {
    const int lane = threadIdx.x & 63, wid = threadIdx.x >> 6;
    const bf16_t* o1 = (const bf16_t*)(p.ws + OFF_V); const bf16_t* o2 = (const bf16_t*)(p.ws + OFF_Q); bf16_t* g = (bf16_t*)(p.ws + OFF_G);
    const f32x4 gh = *(const f32x4*)(p.g_head + 4 * lane);
    for (int idx = blockIdx.x * 8 + wid; idx < ML * 4; idx += gridDim.x * 8) {
        const size_t off = (size_t)(idx >> 2) * 1024 + (idx & 3) * 256 + 4 * lane;
        const u32x2 a = *(const u32x2*)(o1 + off), b = *(const u32x2*)(o2 + off), gs = *(const u32x2*)(g + off);
        float o[4] = {bf_lo(a.x) + bf_lo(b.x), bf_hi(a.x) + bf_hi(b.x), bf_lo(a.y) + bf_lo(b.y), bf_hi(a.y) + bf_hi(b.y)};
        float ss = o[0] * o[0] + o[1] * o[1] + o[2] * o[2] + o[3] * o[3];
        ss = wave_sum(ss);
        const float rs = rsqrtf(ss * (1.f / 256.f) + 1e-6f);
        const float gg[4] = {bf_lo(gs.x), bf_hi(gs.x), bf_lo(gs.y), bf_hi(gs.y)};
        u32x2 w; w.x = pk_bf16(o[0] * rs * gh[0] * gg[0], o[1] * rs * gh[1] * gg[1]); w.y = pk_bf16(o[2] * rs * gh[2] * gg[2], o[3] * rs * gh[3] * gg[3]);
        *(u32x2*)(g + off) = w;
    }
}

__device__ __forceinline__ void run_phase(const Params& p, LAS unsigned char* lds, int ph) {
    unsigned char* ws = p.ws; const float* mod = (const float*)(ws + OFF_MOD);
    const int G = (int)gridDim.x, c = (int)blockIdx.x;
    switch (ph) {
    case 0: phase_prep(p, lds); break;
    case 1: norm_mod_rows(p.x, p.ctx, ML, MT, (bf16_t*)p.out, p.g_mix, mod, 0, 1024); break;
    case 2: { pg8::Gemm g{(const bf16_t*)p.out, (const bf16_t*)(ws + OFF_WIN), MT, NINP, 1024}; pg8::InOrder S; S.init(G, c);
        EpiInProj E{(bf16_t*)(ws + OFF_Q), (bf16_t*)(ws + OFF_K), (bf16_t*)(ws + OFF_V), (bf16_t*)(ws + OFF_G), (bf16_t*)(ws + OFF_CB), (bf16_t*)(ws + OFF_U), (bf16_t*)(ws + OFF_GA), (bf16_t*)(ws + OFF_GB), (float*)(ws + OFF_DD)};
        pg8::gemm_phase(lds, g, S, E); } break;
    case 3: phase_conv(p); break;
    case 4: { pg8::Gemm g{(const bf16_t*)(ws + OFF_CB), (const bf16_t*)(ws + OFF_WCONV), ML, 1024, 1024}; pg8::StaticOrder S; S.init(ML, 1024, G, c);
        EpiGate<0> E{(bf16_t*)(ws + OFF_U), (const bf16_t*)(ws + OFF_GB)}; pg8::gemm_phase(lds, g, S, E); } break;
    case 5: phase_gla_a(p, lds); break;
    case 6: phase_gla_b(p, lds); break;
    case 7: phase_agla(p); break;
    case 8: { pg8::Gemm g{(const bf16_t*)(ws + OFF_G), (const bf16_t*)(ws + OFF_WGLA), ML, 1024, 1024}; pg8::StaticOrder S; S.init(ML, 1024, G, c);
        EpiGate<1> E{(bf16_t*)(ws + OFF_U), (const bf16_t*)(ws + OFF_GA)}; pg8::gemm_phase(lds, g, S, E); } break;
    case 9: { pg8::Gemm g{(const bf16_t*)(ws + OFF_U), (const bf16_t*)(ws + OFF_WMIX), ML, 1024, 1024}; pg8::StaticOrder S; S.init(ML, 1024, G, c);
        EpiRes E{p.x, p.out, mod + 2048}; pg8::gemm_phase(lds, g, S, E); } break;
    case 10: norm_mod_rows(p.out, p.out, ML, ML, (bf16_t*)(ws + OFF_G), p.g_ffn, mod, 3072, 4096); break;
    case 11: { pg8::Gemm g{(const bf16_t*)(ws + OFF_G), (const bf16_t*)(ws + OFF_WFFI), ML, 2 * DFF, 1024}; pg8::StaticOrder S; S.init(ML, 2 * DFF, G, c);
        EpiFfnIn E{(bf16_t*)(ws + OFF_GA)}; pg8::gemm_phase(lds, g, S, E); } break;
    case 12: { pg8::Gemm g{(const bf16_t*)(ws + OFF_GA), (const bf16_t*)(ws + OFF_WFFO), ML, 1024, DFF}; pg8::StaticOrder S; S.init(ML, 1024, G, c);
        EpiRes E{p.out, p.out, mod + 5120}; pg8::gemm_phase(lds, g, S, E); } break;
    case 13: phase_final(p); break;
    default: break;
    }
}

#if FUSED
__global__ void __launch_bounds__(512, 2) mega_fwd(Params p) {
    extern __shared__ __attribute__((aligned(16))) unsigned char shm[];
    LAS unsigned char* lds = (LAS unsigned char*)shm;
    cg::grid_group grid = cg::this_grid();
    for (int ph = 0; ph < NPHASE; ++ph) {
        run_phase(p, lds, ph);
        if (ph + 1 < NPHASE) grid.sync();
    }
}
#else
__global__ void __launch_bounds__(512, 2) mega_fwd(Params p, int ph) {
    extern __shared__ __attribute__((aligned(16))) unsigned char shm[];
    LAS unsigned char* lds = (LAS unsigned char*)shm;
    run_phase(p, lds, ph);
}
#endif

#ifdef PROBE_K
__global__ void digest_k(const bf16_t* arr, size_t lo1, size_t hi1, size_t lo2, size_t hi2, float* out, size_t nout) {
    for (size_t i = (size_t)blockIdx.x * blockDim.x + threadIdx.x; i < nout; i += (size_t)gridDim.x * blockDim.x) {
        float s = 0.f;
        for (size_t j = lo1 + i; j < hi1; j += nout) { const float v = bf2f(arr[j]); s += (__builtin_fabsf(v) < 1e4f) ? v : 0.f; }
        for (size_t j = lo2 + i; j < hi2; j += nout) { const float v = bf2f(arr[j]); s += (__builtin_fabsf(v) < 1e4f) ? v : 0.f; }
        out[i] = s;
    }
}
#endif
extern "C" void kernel_launch(void* const* d_in, const int* in_sizes, int n_in, void* d_out, int out_size, void* d_ws, size_t ws_size, hipStream_t stream) {
    static int grid = 0;
    if (grid == 0) {
        if (n_in != 19 || out_size != ML * DM || ws_size < WS_NEED) { fprintf(stderr, "kernel_launch: unexpected shapes (n_in %d out %d ws %zu need %zu)\n", n_in, out_size, ws_size, (size_t)WS_NEED); grid = -1; return; }
        int dev = 0, cus = 0, per_cu = 0;
        (void)hipGetDevice(&dev); (void)hipDeviceGetAttribute(&cus, hipDeviceAttributeMultiprocessorCount, dev);
        if (hipFuncSetAttribute((const void*)mega_fwd, hipFuncAttributeMaxDynamicSharedMemorySize, LDS_BYTES) != hipSuccess) { fprintf(stderr, "hipFuncSetAttribute failed\n"); grid = -1; return; }
        if (hipOccupancyMaxActiveBlocksPerMultiprocessor(&per_cu, (const void*)mega_fwd, 512, LDS_BYTES) != hipSuccess || per_cu < 1) { fprintf(stderr, "occupancy query failed (%d)\n", per_cu); (void)hipGetLastError(); per_cu = 1; }
        if (per_cu > 1) per_cu = 1;
        grid = cus * per_cu;
    }
    if (grid < 0) return;
    Params p{};
    const float** f = (const float**)&p;
    for (int i = 0; i < 19; ++i) f[i] = (const float*)d_in[i];
    p.out = (float*)d_out; p.ws = (unsigned char*)d_ws;
#if FUSED
    void* args[] = {&p};
    hipError_t e = hipLaunchCooperativeKernel((const void*)mega_fwd, dim3(grid), dim3(512), args, LDS_BYTES, stream);
    if (e != hipSuccess) fprintf(stderr, "cooperative launch failed: %s (grid %d)\n", hipGetErrorString(e), grid);
#else
#ifdef PROBE_K
    for (int ph = 0; ph <= PROBE_K; ++ph) hipLaunchKernelGGL(mega_fwd, dim3(grid), dim3(512), LDS_BYTES, stream, p, ph);
    hipLaunchKernelGGL(digest_k, dim3(2048), dim3(256), 0, stream, (const bf16_t*)d_ws, (size_t)(OFF_DEC / 2), (size_t)(OFF_DD / 2), (size_t)(OFF_CB / 2), (size_t)(OFF_GB / 2), (float*)d_out, (size_t)ML * DM);
#else
    for (int ph = 0; ph < NPHASE; ++ph) hipLaunchKernelGGL(mega_fwd, dim3(grid), dim3(512), LDS_BYTES, stream, p, ph);
#endif
#endif
}
```

```cpp
#include <hip/hip_runtime.h>
#include <hip/hip_cooperative_groups.h>
#include <cstdio>
namespace cg = cooperative_groups;

#ifndef FUSED
#define FUSED 1
#endif

#define LAS __attribute__((address_space(3)))
typedef unsigned short bf16_t;
typedef short bf16x8 __attribute__((ext_vector_type(8)));
typedef float f32x4 __attribute__((ext_vector_type(4)));
typedef unsigned u32x4 __attribute__((ext_vector_type(4)));
typedef unsigned u32x2 __attribute__((ext_vector_type(2)));

constexpr int DM = 1024, NB = 8, SEQ = 4096, CTXL = 256;
constexpr int ML = NB * SEQ, MC = NB * CTXL, MT = ML + MC;
constexpr int DFF = 2816, NIN = 8224, NINP = 8448, NCH = 68;
constexpr int LDS_BYTES = 131072;
constexpr int NPHASE = 14;

constexpr size_t OFF_WIN = 0;
constexpr size_t OFF_WGLA = OFF_WIN + (size_t)NINP * 1024 * 2;
constexpr size_t OFF_WCONV = OFF_WGLA + 2097152;
constexpr size_t OFF_WMIX = OFF_WCONV + 2097152;
constexpr size_t OFF_WFFI = OFF_WMIX + 2097152;
constexpr size_t OFF_WFFO = OFF_WFFI + (size_t)5632 * 1024 * 2;
constexpr size_t OFF_MOD = OFF_WFFO + (size_t)1024 * 2816 * 2;
constexpr size_t OFF_DEC = OFF_MOD + (size_t)9 * 6144 * 4;
constexpr size_t OFF_DD = OFF_DEC + (size_t)2 * 8 * 4 * NCH * 128 * 4;
constexpr size_t OFF_Q = OFF_DD + (size_t)MT * 32 * 4;
constexpr size_t OFF_K = OFF_Q + (size_t)ML * 512 * 2;
constexpr size_t OFF_V = OFF_K + (size_t)MT * 512 * 2;
constexpr size_t OFF_G = OFF_V + (size_t)MT * 1024 * 2;
constexpr size_t OFF_GA = OFF_G + (size_t)ML * 1024 * 2;
constexpr size_t OFF_U = OFF_GA + (size_t)ML * 1024 * 2;
constexpr size_t OFF_CB = OFF_U + (size_t)ML * 1024 * 2;
constexpr size_t OFF_GB = OFF_CB + (size_t)ML * 1024 * 2;
constexpr size_t WS_NEED = OFF_GB + (size_t)NB * 4 * NCH * 256 * 64 * 2;

struct Params {
    const float *x, *c, *ctx, *c_ctx, *w_ada, *b_ada, *g_mix, *w_in, *w_dec_up, *b_dec, *g_head, *w_gla_out, *w_conv, *w_conv_out,
        *w_mix_out, *g_ffn, *w_ffn_in, *w_ffn_out, *g_final;
    float* out;
    unsigned char* ws;
};

typedef __bf16 bf16v2_t __attribute__((ext_vector_type(2)));
typedef float f32x2_t __attribute__((ext_vector_type(2)));
__device__ __forceinline__ unsigned pk_bf16(float lo, float hi) { const f32x2_t v = {lo, hi}; const bf16v2_t b = __builtin_convertvector(v, bf16v2_t); return __builtin_bit_cast(unsigned, b); }
__device__ __forceinline__ float bf_lo(unsigned w) { return __uint_as_float(w << 16); }
__device__ __forceinline__ float bf_hi(unsigned w) { return __uint_as_float(w & 0xffff0000u); }
__device__ __forceinline__ float bf2f(bf16_t b) { return __uint_as_float(((unsigned)b) << 16); }
__device__ __forceinline__ bf16_t f2bf(float f) { return (bf16_t)(pk_bf16(f, 0.f) & 0xffffu); }
__device__ __forceinline__ float wave_sum(float v) {
#pragma unroll
    for (int o = 32; o > 0; o >>= 1) v += __shfl_xor(v, o);
    return v;
}
__device__ __forceinline__ float sigmoidf_(float v) { return __builtin_amdgcn_rcpf(1.f + __expf(-v)); }

namespace pg8 {
constexpr int BM = 256, BK = 64, HALF = 128, HTB = HALF * BK * 2, NXCD = 8, WGM = 8;
__device__ __forceinline__ int lds_byte(int r, int c) { const int st = (r >> 4) * 2 + (c >> 5), rr = r & 15, cc = c & 31, ob = rr * 64 + cc * 2; return st * 1024 + (ob ^ (((ob >> 9) & 1) << 5)); }
__device__ __forceinline__ void stage_rc(int b, int& R, int& C) { const int st = b / 1024, sb = b % 1024, swz = sb ^ (((sb >> 9) & 1) << 5); R = (st >> 1) * 16 + swz / 64; C = (st & 1) * 32 + (swz % 64) / 2; }
__device__ __forceinline__ int perm32(int rho) { const int n = rho >> 4, i = rho & 15; return 8 * (i >> 2) + 4 * n + (i & 3); }
struct Unit { int pm, pn; };
struct Gemm { const bf16_t* A; const bf16_t* Bt; int M, N, K; };

struct StaticOrder {
    int nM, nN, nwg, G, c;
    __device__ void init(int M, int N, int G_, int c_) { nM = M / BM; nN = N / BM; nwg = nM * nN; G = G_; c = c_; }
    __device__ bool next(int i, Unit& u) const {
        const long L = (long)i * G + c; if (L >= nwg) return false;
        int wgid = (int)L; { const int q = nwg / NXCD, r = nwg % NXCD, xcd = wgid % NXCD, off = wgid / NXCD; wgid = (xcd < r ? xcd * (q + 1) : r * (q + 1) + (xcd - r) * q) + off; }
        const int nig = WGM * nN, gid = wgid / nig, fm = gid * WGM, gsz = (nM - fm) < WGM ? (nM - fm) : WGM;
        u.pm = fm + ((wgid % nig) % gsz); u.pn = (wgid % nig) / gsz; return true;
    }
};
struct InOrder {
    StaticOrder so;
    __device__ void init(int G_, int c_) { so.init(ML, NINP, G_, c_); }
    __device__ bool next(int i, Unit& u) const {
        const long L = (long)i * so.G + so.c;
        if (L < so.nwg) return so.next(i, u);
        const int j = (int)(L - so.nwg); if (j >= 56) return false;
        u.pm = 128 + j / 7; const int cc = j % 7; u.pn = cc < 2 ? 2 + cc : (cc < 6 ? 4 + (cc - 2) : 32); return true;
    }
};

template <class Epi, class Sched>
__device__ __forceinline__ void gemm_phase(LAS unsigned char* lds, const Gemm g, const Sched& S, const Epi& E) {
    const int tid = threadIdx.x, wid = __builtin_amdgcn_readfirstlane(tid >> 6), lane = tid & 63, wr = wid >> 2, wc = wid & 3, fr = lane & 15, fq = lane >> 4;
    const int K = g.K, nt = K / BK;
    unsigned voffA[2], voffB[2];
#pragma unroll
    for (int i = 0; i < 2; ++i) { int R, C; stage_rc(tid * 16 + i * 8192, R, C); const int Rb = Epi::PERM ? ((R & ~31) + perm32(R & 31)) : R;
        voffA[i] = (unsigned)(R * K + C) * 2u; voffB[i] = (unsigned)(Rb * K + C) * 2u; }
    const size_t kstep = (size_t)(BK * 2);
    const size_t hstep = (size_t)HALF * K * 2;
    const size_t tstep = 2 * hstep;
    const unsigned ldsw = (unsigned)wid * 1024u;
    const int aoff = lds_byte(wr * 64 + fr, fq * 8), boff = lds_byte(wc * 32 + fr, fq * 8);
#define PG8_SA(b, h) (((b) * 2 + (h)) * HTB)
#define PG8_SB(b, h) ((4 + (b) * 2 + (h)) * HTB)
#define PG8_STAGE(bufoff, gbase, voff) do { _Pragma("unroll") for (int _i = 0; _i < 2; ++_i) \
        __builtin_amdgcn_global_load_lds((const unsigned*)((const char*)(gbase) + (voff)[_i]), (LAS unsigned*)(lds + (bufoff) + ldsw + _i * 8192), 16, 0, 0); } while (0)
#define PG8_LDA(dst, b, h) do { _Pragma("unroll") for (int m = 0; m < 4; ++m) _Pragma("unroll") for (int k = 0; k < 2; ++k) dst[m][k] = *(const LAS bf16x8*)(lds + PG8_SA(b, h) + aoff + m * 2048 + k * 1024); } while (0)
#define PG8_LDB(dst, b, h) do { _Pragma("unroll") for (int n = 0; n < 2; ++n) _Pragma("unroll") for (int k = 0; k < 2; ++k) dst[n][k] = *(const LAS bf16x8*)(lds + PG8_SB(b, h) + boff + n * 2048 + k * 1024); } while (0)
#define PG8_MMA(ai, bj, At, Bt) do { __builtin_amdgcn_s_setprio(1); _Pragma("unroll") for (int m = 0; m < 4; ++m) _Pragma("unroll") for (int n = 0; n < 2; ++n) _Pragma("unroll") for (int k = 0; k < 2; ++k) \
        acc[ai][bj][m][n] = __builtin_amdgcn_mfma_f32_16x16x32_bf16(Bt[n][k], At[m][k], acc[ai][bj][m][n], 0, 0, 0); __builtin_amdgcn_s_setprio(0); } while (0)
#define PG8_WAIT_V(n) asm volatile("s_waitcnt vmcnt(" #n ")" ::: "memory")
#define PG8_WAIT_L(n) asm volatile("s_waitcnt lgkmcnt(" #n ")" ::: "memory")
#define PG8_BAR __builtin_amdgcn_s_barrier()
#define PG8_SCHED __builtin_amdgcn_sched_barrier(0)
    Unit cur, nxt; int ui = 0;
    if (!S.next(0, cur)) return;
    f32x4 acc[2][2][4][2];
#pragma unroll
    for (int a = 0; a < 2; ++a)
#pragma unroll
        for (int b = 0; b < 2; ++b)
#pragma unroll
            for (int m = 0; m < 4; ++m)
#pragma unroll
                for (int n = 0; n < 2; ++n) acc[a][b][m][n] = (f32x4){0.f, 0.f, 0.f, 0.f};
    bf16x8 At[4][2], B0[2][2], B1[2][2];
    const char* cA = (const char*)g.A + (size_t)cur.pm * tstep; const char* cB = (const char*)g.Bt + (size_t)cur.pn * tstep;
    PG8_STAGE(PG8_SB(0, 0), cB, voffB); PG8_STAGE(PG8_SA(0, 0), cA, voffA); PG8_STAGE(PG8_SB(0, 1), cB + hstep, voffB); PG8_STAGE(PG8_SA(0, 1), cA + hstep, voffA);
    if (wr == 1) PG8_BAR;
    PG8_WAIT_V(4); PG8_BAR;
    PG8_STAGE(PG8_SB(1, 0), cB + kstep, voffB); PG8_STAGE(PG8_SA(1, 0), cA + kstep, voffA); PG8_STAGE(PG8_SB(1, 1), cB + hstep + kstep, voffB);
    PG8_WAIT_V(6); PG8_BAR;
    for (;;) {
        const bool has_next = S.next(ui + 1, nxt);
        const char* nA = has_next ? (const char*)g.A + (size_t)nxt.pm * tstep : cA; const char* nB = has_next ? (const char*)g.Bt + (size_t)nxt.pn * tstep : cB;
        for (int t = 0; t < nt; t += 2) {
            const bool last = (t == nt - 2);
            const char* a1 = cA + (size_t)(t + 1) * kstep;
            const char* a2 = last ? nA : cA + (size_t)(t + 2) * kstep; const char* b2 = last ? nB : cB + (size_t)(t + 2) * kstep;
            const char* a3 = a2 + kstep; const char* b3 = b2 + kstep;
            PG8_LDB(B0, 0, 0); PG8_SCHED; PG8_LDA(At, 0, 0); PG8_STAGE(PG8_SA(1, 1), a1 + hstep, voffA);
            PG8_WAIT_L(8); PG8_BAR; PG8_WAIT_L(0); PG8_MMA(0, 0, At, B0); PG8_BAR; PG8_SCHED;
            PG8_LDB(B1, 0, 1); PG8_STAGE(PG8_SB(0, 0), b2, voffB);
            PG8_BAR; PG8_WAIT_L(0); PG8_MMA(0, 1, At, B1); PG8_BAR;
            PG8_LDA(At, 0, 1); PG8_STAGE(PG8_SA(0, 0), a2, voffA);
            PG8_BAR; PG8_WAIT_L(0); PG8_MMA(1, 0, At, B0); PG8_BAR; PG8_SCHED;
            PG8_STAGE(PG8_SB(0, 1), b2 + hstep, voffB);
            PG8_WAIT_V(6); PG8_BAR; PG8_MMA(1, 1, At, B1); PG8_BAR;
            PG8_LDB(B0, 1, 0); PG8_SCHED; PG8_LDA(At, 1, 0); PG8_STAGE(PG8_SA(0, 1), a2 + hstep, voffA);
            PG8_WAIT_L(8); PG8_BAR; PG8_WAIT_L(0); PG8_MMA(0, 0, At, B0); PG8_BAR; PG8_SCHED;
            PG8_LDB(B1, 1, 1); PG8_STAGE(PG8_SB(1, 0), b3, voffB);
            PG8_BAR; PG8_WAIT_L(0); PG8_MMA(0, 1, At, B1); PG8_BAR;
            PG8_LDA(At, 1, 1); PG8_STAGE(PG8_SA(1, 0), a3, voffA);
            PG8_BAR; PG8_WAIT_L(0); PG8_MMA(1, 0, At, B0); PG8_BAR; PG8_SCHED;
            PG8_STAGE(PG8_SB(1, 1), b3 + hstep, voffB);
            PG8_WAIT_V(6); PG8_BAR; PG8_MMA(1, 1, At, B1); PG8_BAR;
        }
        E(acc, cur, wr, wc, fr, fq);
        if (!has_next) break;
#pragma unroll
        for (int a = 0; a < 2; ++a)
#pragma unroll
            for (int b = 0; b < 2; ++b)
#pragma unroll
                for (int m = 0; m < 4; ++m)
#pragma unroll
                    for (int n = 0; n < 2; ++n) acc[a][b][m][n] = (f32x4){0.f, 0.f, 0.f, 0.f};
        cur = nxt; cA = nA; cB = nB; ++ui;
    }
    PG8_WAIT_V(0);
    if (wr == 0) PG8_BAR;
    PG8_BAR;
#undef PG8_SA
#undef PG8_SB
#undef PG8_STAGE
#undef PG8_LDA
#undef PG8_LDB
#undef PG8_MMA
#undef PG8_WAIT_V
#undef PG8_WAIT_L
#undef PG8_BAR
#undef PG8_SCHED
}
}
using pg8::Unit;

struct EpiInProj {
    static constexpr bool PERM = true;
    bf16_t *q, *k, *v, *g, *cb, *u, *ga, *gb; float* dd;
    __device__ __forceinline__ void operator()(const f32x4 (&acc)[2][2][4][2], const Unit& un, int wr, int wc, int fr, int fq) const {
        const int pn = un.pn; const size_t row0 = (size_t)un.pm * 256 + wr * 64 + fr;
        if (pn < 16 || (pn >= 24 && pn < 32)) {
            bf16_t* base; int ldc, colt, act;
            if (pn < 2) { base = q; ldc = 512; colt = pn * 256; act = 0; }
            else if (pn < 4) { base = k; ldc = 512; colt = (pn - 2) * 256; act = 0; }
            else if (pn < 8) { base = v; ldc = 1024; colt = (pn - 4) * 256; act = 0; }
            else if (pn < 12) { base = g; ldc = 1024; colt = (pn - 8) * 256; act = 1; }
            else if (pn < 16) { base = cb; ldc = 1024; colt = (pn - 12) * 256; act = 0; }
            else if (pn < 28) { base = ga; ldc = 1024; colt = (pn - 24) * 256; act = 2; }
            else { base = gb; ldc = 1024; colt = (pn - 28) * 256; act = 2; }
            const int col0 = colt + wc * 32 + 8 * fq;
#pragma unroll
            for (int ai = 0; ai < 2; ++ai)
#pragma unroll
                for (int m = 0; m < 4; ++m) { bf16_t* rowp = base + (row0 + ai * 128 + m * 16) * ldc + col0;
#pragma unroll
                    for (int bj = 0; bj < 2; ++bj) { f32x4 v0 = acc[ai][bj][m][0], v1 = acc[ai][bj][m][1];
                        if (act) {
#pragma unroll
                            for (int j = 0; j < 4; ++j) { const float s0 = sigmoidf_(v0[j]), s1 = sigmoidf_(v1[j]); v0[j] = act == 1 ? v0[j] * s0 : s0; v1[j] = act == 1 ? v1[j] * s1 : s1; } }
                        u32x4 w; w.x = pk_bf16(v0[0], v0[1]); w.y = pk_bf16(v0[2], v0[3]); w.z = pk_bf16(v1[0], v1[1]); w.w = pk_bf16(v1[2], v1[3]);
                        *(u32x4*)(rowp + bj * 128) = w; } }
        } else if (pn < 24) {
            const int col0 = (pn - 16) * 128 + wc * 32 + 8 * fq;
#pragma unroll
            for (int ai = 0; ai < 2; ++ai)
#pragma unroll
                for (int m = 0; m < 4; ++m) { const f32x4 v0 = acc[ai][0][m][0] * acc[ai][1][m][0], v1 = acc[ai][0][m][1] * acc[ai][1][m][1];
                    u32x4 w; w.x = pk_bf16(v0[0], v0[1]); w.y = pk_bf16(v0[2], v0[3]); w.z = pk_bf16(v1[0], v1[1]); w.w = pk_bf16(v1[2], v1[3]);
                    *(u32x4*)(u + (row0 + ai * 128 + m * 16) * 1024 + col0) = w; }
        } else {
            if (wc == 0) {
#pragma unroll
                for (int ai = 0; ai < 2; ++ai)
#pragma unroll
                    for (int m = 0; m < 4; ++m) { float* rp = dd + (row0 + ai * 128 + m * 16) * 32 + 8 * fq;
                        *(f32x4*)rp = acc[ai][0][m][0]; *(f32x4*)(rp + 4) = acc[ai][0][m][1]; }
            }
        }
    }
};
template <int MODE> struct EpiGate {
    static constexpr bool PERM = true;
    bf16_t* T; const bf16_t* sg;
    __device__ __forceinline__ void operator()(const f32x4 (&acc)[2][2][4][2], const Unit& un, int wr, int wc, int fr, int fq) const {
        const size_t row0 = (size_t)un.pm * 256 + wr * 64 + fr; const int col0 = un.pn * 256 + wc * 32 + 8 * fq;
#pragma unroll
        for (int ai = 0; ai < 2; ++ai)
#pragma unroll
            for (int m = 0; m < 4; ++m)
#pragma unroll
                for (int bj = 0; bj < 2; ++bj) { const size_t off = (row0 + ai * 128 + m * 16) * 1024 + col0 + bj * 128;
                    const u32x4 s = *(const u32x4*)(sg + off); const f32x4 a0 = acc[ai][bj][m][0], a1 = acc[ai][bj][m][1];
                    float o[8] = {a0[0] * bf_lo(s.x), a0[1] * bf_hi(s.x), a0[2] * bf_lo(s.y), a0[3] * bf_hi(s.y), a1[0] * bf_lo(s.z), a1[1] * bf_hi(s.z), a1[2] * bf_lo(s.w), a1[3] * bf_hi(s.w)};
                    if (MODE == 1) { const u32x4 t = *(const u32x4*)(T + off);
                        o[0] += bf_lo(t.x); o[1] += bf_hi(t.x); o[2] += bf_lo(t.y); o[3] += bf_hi(t.y); o[4] += bf_lo(t.z); o[5] += bf_hi(t.z); o[6] += bf_lo(t.w); o[7] += bf_hi(t.w); }
                    u32x4 w; w.x = pk_bf16(o[0], o[1]); w.y = pk_bf16(o[2], o[3]); w.z = pk_bf16(o[4], o[5]); w.w = pk_bf16(o[6], o[7]);
                    *(u32x4*)(T + off) = w; }
    }
};
struct EpiRes {
    static constexpr bool PERM = true;
    const float* xin; float* out; const float* gate;
    __device__ __forceinline__ void operator()(const f32x4 (&acc)[2][2][4][2], const Unit& un, int wr, int wc, int fr, int fq) const {
        const size_t row0 = (size_t)un.pm * 256 + wr * 64 + fr; const int col0 = un.pn * 256 + wc * 32 + 8 * fq;
        const float* gp = gate + (size_t)(un.pm >> 4) * 6144 + col0;
        f32x4 gv[2][2];
#pragma unroll
        for (int bj = 0; bj < 2; ++bj)
#pragma unroll
            for (int n = 0; n < 2; ++n) gv[bj][n] = *(const f32x4*)(gp + bj * 128 + 4 * n);
#pragma unroll
        for (int ai = 0; ai < 2; ++ai)
#pragma unroll
            for (int m = 0; m < 4; ++m)
#pragma unroll
                for (int bj = 0; bj < 2; ++bj)
#pragma unroll
                    for (int n = 0; n < 2; ++n) { const size_t off = (row0 + ai * 128 + m * 16) * 1024 + col0 + bj * 128 + 4 * n;
                        const f32x4 xv = *(const f32x4*)(xin + off); *(f32x4*)(out + off) = xv + gv[bj][n] * acc[ai][bj][m][n]; }
    }
};
struct EpiFfnIn {
    static constexpr bool PERM = true;
    bf16_t* s;
    __device__ __forceinline__ void operator()(const f32x4 (&acc)[2][2][4][2], const Unit& un, int wr, int wc, int fr, int fq) const {
        const size_t row0 = (size_t)un.pm * 256 + wr * 64 + fr; const int col0 = un.pn * 128 + wc * 32 + 8 * fq;
#pragma unroll
        for (int ai = 0; ai < 2; ++ai)
#pragma unroll
            for (int m = 0; m < 4; ++m) { float o[8];
#pragma unroll
                for (int n = 0; n < 2; ++n)
#pragma unroll
                    for (int j = 0; j < 4; ++j) { const float a = acc[ai][0][m][n][j], b = acc[ai][1][m][n][j]; o[4 * n + j] = a * sigmoidf_(a) * b; }
                u32x4 w; w.x = pk_bf16(o[0], o[1]); w.y = pk_bf16(o[2], o[3]); w.z = pk_bf16(o[4], o[5]); w.w = pk_bf16(o[6], o[7]);
                *(u32x4*)(s + (row0 + ai * 128 + m * 16) * DFF + col0) = w; }
    }
};

__device__ __forceinline__ void adaln_item(const Params& p, LAS unsigned char* lds, int it) {
    const int tid = threadIdx.x, lane = tid & 63, wid = tid >> 6;
    LAS float* sl = (LAS float*)lds;
    LAS float* red = sl + 9 * 1024;
    for (int i = tid; i < 9 * 1024; i += 512) { const int r = i >> 10, k = i & 1023; const float cv = r < 8 ? p.c[r * 1024 + k] : p.c_ctx[k]; sl[i] = cv / (1.f + __expf(-cv)); }
    __syncthreads();
    const int c0 = 32 * it, kg = tid >> 3, cq = tid & 7;
    float acc[9][4];
#pragma unroll
    for (int r = 0; r < 9; ++r)
#pragma unroll
        for (int j = 0; j < 4; ++j) acc[r][j] = 0.f;
    for (int kk = 0; kk < 16; ++kk) { const int k = kg * 16 + kk; const f32x4 w = *(const f32x4*)(p.w_ada + (size_t)k * 6144 + c0 + 4 * cq);
#pragma unroll
        for (int r = 0; r < 9; ++r) { const float s = sl[r * 1024 + k];
#pragma unroll
            for (int j = 0; j < 4; ++j) acc[r][j] += s * w[j]; } }
#pragma unroll
    for (int r = 0; r < 9; ++r)
#pragma unroll
        for (int j = 0; j < 4; ++j) { float v = acc[r][j]; v += __shfl_xor(v, 8); v += __shfl_xor(v, 16); v += __shfl_xor(v, 32); acc[r][j] = v; }
    if ((lane >> 3) == 0) {
#pragma unroll
        for (int r = 0; r < 9; ++r)
#pragma unroll
            for (int j = 0; j < 4; ++j) red[(wid * 9 + r) * 32 + 4 * cq + j] = acc[r][j]; }
    __syncthreads();
    if (tid < 288) { const int r = tid >> 5, cc = tid & 31; float s = 0.f;
#pragma unroll
        for (int w = 0; w < 8; ++w) s += red[(w * 9 + r) * 32 + cc];
        ((float*)(p.ws + OFF_MOD))[r * 6144 + c0 + cc] = s + p.b_ada[c0 + cc]; }
}
__device__ __forceinline__ void wconv_tile(const Params& p, LAS unsigned char* lds, int j) {
    const int tid = threadIdx.x;
    const float* src; bf16_t* dst; int sld, dld, nt, kt, srccol, nvalid = 64;
    if (j < 2112) { nt = j >> 4; kt = j & 15; src = p.w_in; sld = NIN; dst = (bf16_t*)(p.ws + OFF_WIN); dld = 1024;
        const int n0 = nt * 64;
        if (n0 < 3072) srccol = n0;
        else if (n0 < 4096) srccol = 3104 + (n0 - 3072);
        else if (n0 < 6144) { const int i = n0 - 4096, pt = i >> 8, w = i & 255; srccol = w < 128 ? 4128 + 128 * pt + w : 5152 + 128 * pt + (w - 128); }
        else if (n0 < 7168) srccol = 6176 + (n0 - 6144);
        else if (n0 < 8192) srccol = 7200 + (n0 - 7168);
        else if (n0 == 8192) { srccol = 3072; nvalid = 32; }
        else { srccol = 0; nvalid = 0; }
    } else if (j < 2880) { const int jj = j - 2112, mi = jj >> 8, r = jj & 255; nt = r >> 4; kt = r & 15; sld = 1024; dld = 1024; srccol = nt * 64;
        src = mi == 0 ? p.w_gla_out : (mi == 1 ? p.w_conv_out : p.w_mix_out); dst = (bf16_t*)(p.ws + (mi == 0 ? OFF_WGLA : (mi == 1 ? OFF_WCONV : OFF_WMIX)));
    } else if (j < 4288) { const int jj = j - 2880; nt = jj >> 4; kt = jj & 15; src = p.w_ffn_in; sld = 2 * DFF; dst = (bf16_t*)(p.ws + OFF_WFFI); dld = 1024;
        const int n0 = nt * 64, pt = n0 >> 8, w = n0 & 255; srccol = w < 128 ? 128 * pt + w : DFF + 128 * pt + (w - 128);
    } else { const int jj = j - 4288; nt = jj / 44; kt = jj % 44; src = p.w_ffn_out; sld = 1024; dst = (bf16_t*)(p.ws + OFF_WFFO); dld = DFF; srccol = nt * 64; }
    const int n0 = nt * 64, k0 = kt * 64;
    LAS float* tile = (LAS float*)lds;
    { const int jc = tid & 63, kk0 = tid >> 6;
#pragma unroll
        for (int i = 0; i < 8; ++i) { const int kk = kk0 + 8 * i; tile[kk * 65 + jc] = jc < nvalid ? src[(size_t)(k0 + kk) * sld + srccol + jc] : 0.f; } }
    __syncthreads();
    { const int jr = tid >> 3, kg = tid & 7; float v[8];
#pragma unroll
        for (int e = 0; e < 8; ++e) v[e] = tile[(8 * kg + e) * 65 + jr];
        u32x4 w; w.x = pk_bf16(v[0], v[1]); w.y = pk_bf16(v[2], v[3]); w.z = pk_bf16(v[4], v[5]); w.w = pk_bf16(v[6], v[7]);
        *(u32x4*)(dst + (size_t)(n0 + jr) * dld + k0 + 8 * kg) = w; }
}
__device__ void phase_prep(const Params& p, LAS unsigned char* lds) {
    constexpr int NADA = 192, NTILES = 2112 + 768 + 1408 + 704;
    for (int it = blockIdx.x; it < NADA + NTILES; it += gridDim.x) {
        if (it < NADA) adaln_item(p, lds, it); else wconv_tile(p, lds, it - NADA);
        __syncthreads();
    }
}

__device__ __forceinline__ void norm_mod_rows(const float* src0, const float* src1, int nrows0, int nrows, bf16_t* dst, const float* gw, const float* mod, int sh_off, int sc_off) {
    const int lane = threadIdx.x & 63, wid = threadIdx.x >> 6;
    for (int row = blockIdx.x * 8 + wid; row < nrows; row += gridDim.x * 8) {
        const float* s = row < nrows0 ? src0 + (size_t)row * 1024 : src1 + (size_t)(row - nrows0) * 1024;
        const int mr = row < nrows0 ? row / SEQ : 8;
        f32x4 v[4];
        v[0] = *(const f32x4*)(s + 8 * lane); v[1] = *(const f32x4*)(s + 8 * lane + 4); v[2] = *(const f32x4*)(s + 512 + 8 * lane); v[3] = *(const f32x4*)(s + 512 + 8 * lane + 4);
        float ss = 0.f;
#pragma unroll
        for (int i = 0; i < 4; ++i)
#pragma unroll
            for (int j = 0; j < 4; ++j) ss += v[i][j] * v[i][j];
        ss = wave_sum(ss);
        const float rs = rsqrtf(ss * (1.f / 1024.f) + 1e-6f);
        const float* mp = mod + (size_t)mr * 6144;
#pragma unroll
        for (int hh = 0; hh < 2; ++hh) { const int c = hh * 512 + 8 * lane; float o[8];
#pragma unroll
            for (int q = 0; q < 2; ++q) { const f32x4 gg = *(const f32x4*)(gw + c + 4 * q), sc = *(const f32x4*)(mp + sc_off + c + 4 * q), sh = *(const f32x4*)(mp + sh_off + c + 4 * q);
#pragma unroll
                for (int j = 0; j < 4; ++j) o[4 * q + j] = (v[2 * hh + q][j] * rs * gg[j]) * (1.f + sc[j]) + sh[j]; }
            u32x4 w; w.x = pk_bf16(o[0], o[1]); w.y = pk_bf16(o[2], o[3]); w.z = pk_bf16(o[4], o[5]); w.w = pk_bf16(o[6], o[7]);
            *(u32x4*)(dst + (size_t)row * 1024 + c) = w; }
    }
}
__device__ void phase_final(const Params& p) {
    const int lane = threadIdx.x & 63, wid = threadIdx.x >> 6;
    for (int row = blockIdx.x * 8 + wid; row < ML; row += gridDim.x * 8) {
        float* s = p.out + (size_t)row * 1024;
        f32x4 v[4];
        v[0] = *(const f32x4*)(s + 8 * lane); v[1] = *(const f32x4*)(s + 8 * lane + 4); v[2] = *(const f32x4*)(s + 512 + 8 * lane); v[3] = *(const f32x4*)(s + 512 + 8 * lane + 4);
        float ss = 0.f;
#pragma unroll
        for (int i = 0; i < 4; ++i)
#pragma unroll
            for (int j = 0; j < 4; ++j) ss += v[i][j] * v[i][j];
        ss = wave_sum(ss);
        const float rs = rsqrtf(ss * (1.f / 1024.f) + 1e-6f);
#pragma unroll
        for (int i = 0; i < 4; ++i) { const int c = (i >> 1) * 512 + 8 * lane + 4 * (i & 1); const f32x4 gg = *(const f32x4*)(p.g_final + c); f32x4 o = v[i] * rs * gg;
            *(f32x4*)(s + c) = o; }
    }
}

__device__ void phase_conv(const Params& p) {
    bf16_t* cb = (bf16_t*)(p.ws + OFF_CB); const bf16_t* u = (const bf16_t*)(p.ws + OFF_U);
    const int total = ML * 128;
    for (int i = blockIdx.x * 512 + threadIdx.x; i < total; i += gridDim.x * 512) {
        const int t = i >> 7, c = (i & 127) * 8, tl = t & 63; const size_t off = (size_t)t * 1024 + c;
        const u32x4 z = {0u, 0u, 0u, 0u};
        const u32x4 u0 = *(const u32x4*)(u + off), um = tl > 0 ? *(const u32x4*)(u + off - 1024) : z, up = tl < 63 ? *(const u32x4*)(u + off + 1024) : z, cv = *(const u32x4*)(cb + off);
        float w0[8], w1[8], w2[8];
#pragma unroll
        for (int q = 0; q < 2; ++q) { const f32x4 a = *(const f32x4*)(p.w_conv + c + 4 * q), b = *(const f32x4*)(p.w_conv + 1024 + c + 4 * q), d = *(const f32x4*)(p.w_conv + 2048 + c + 4 * q);
#pragma unroll
            for (int j = 0; j < 4; ++j) { w0[4 * q + j] = a[j]; w1[4 * q + j] = b[j]; w2[4 * q + j] = d[j]; } }
        float o[8];
#pragma unroll
        for (int e = 0; e < 4; ++e) {
            const unsigned a = um[e], b = u0[e], d = up[e], cc = cv[e];
            o[2 * e] = bf_lo(cc) * (bf_lo(a) * w0[2 * e] + bf_lo(b) * w1[2 * e] + bf_lo(d) * w2[2 * e]);
            o[2 * e + 1] = bf_hi(cc) * (bf_hi(a) * w0[2 * e + 1] + bf_hi(b) * w1[2 * e + 1] + bf_hi(d) * w2[2 * e + 1]);
        }
        u32x4 w; w.x = pk_bf16(o[0], o[1]); w.y = pk_bf16(o[2], o[3]); w.z = pk_bf16(o[4], o[5]); w.w = pk_bf16(o[6], o[7]);
        *(u32x4*)(cb + off) = w;
    }
}

constexpr int A_DD = 0, A_QR = 8192, A_KR = 25600, A_HT = 43008, A_QD = 45056, A_KD = 79872, A_P = 114688, A_VT = 8192;
constexpr int A_RS = 272;
constexpr int A_PS = 144;
constexpr float QSCALE = 0.08838834764831845f;

template <int DIR>
__device__ __forceinline__ void gla_pass2(LAS unsigned char* lds, const float (&la)[32], int ch, int half, bool lat, float bmid, float blast, float start, bf16_t* q2g  , bf16_t* k2g  ) {
    float b = start; unsigned kp[16];
#pragma unroll
    for (int s = 0; s < 32; ++s) {
        const int i = DIR == 0 ? s : 31 - s; const int t = half * 32 + i;
        b += la[i];
        const float kk = bf2f(*(const LAS bf16_t*)(lds + A_KR + t * A_RS + ch * 2));
        const float k2 = kk * __expf(blast - b);
        const unsigned kb = pk_bf16(k2, 0.f) & 0xffffu;
        if ((i & 1) == 0) kp[i >> 1] = (DIR == 0) ? kb : (kp[i >> 1] | kb); else kp[i >> 1] = (DIR == 0) ? (kp[i >> 1] | (kb << 16)) : (kb << 16);
        if (lat) {
            const float qq = bf2f(*(const LAS bf16_t*)(lds + A_QR + t * A_RS + ch * 2)) * QSCALE;
            *(LAS bf16_t*)(lds + A_QD + DIR * 17408 + t * A_RS + ch * 2) = f2bf(qq * __expf(b - bmid));
            *(LAS bf16_t*)(lds + A_KD + DIR * 17408 + t * A_RS + ch * 2) = f2bf(kk * __expf(bmid - b));
            q2g[(size_t)t * 512] = f2bf(qq * __expf(b));
        }
    }
#pragma unroll
    for (int g4 = 0; g4 < 4; ++g4) { u32x4 w; w.x = kp[4 * g4]; w.y = kp[4 * g4 + 1]; w.z = kp[4 * g4 + 2]; w.w = kp[4 * g4 + 3]; *(u32x4*)(k2g + 8 * g4) = w; }
}

__device__ void phase_gla_a(const Params& p, LAS unsigned char* lds) {
    const int tid = threadIdx.x, lane = tid & 63, wid = tid >> 6, fr = lane & 15, fq = lane >> 4;
    const float* dd = (const float*)(p.ws + OFF_DD);
    const bf16_t* qb = (const bf16_t*)(p.ws + OFF_Q); const bf16_t* kb = (const bf16_t*)(p.ws + OFF_K);
    bf16_t* vb = (bf16_t*)(p.ws + OFF_V);
    bf16_t* Q2 = (bf16_t*)(p.ws + OFF_CB); bf16_t* K2T = (bf16_t*)p.out; bf16_t* VT = (bf16_t*)(p.ws + OFF_GB); float* dec = (float*)(p.ws + OFF_DEC);
    for (int it = blockIdx.x; it < 2048 + 128; it += gridDim.x) {
        const bool lat = it < 2048;
        int b, c, h; size_t row0; int cidx;
        if (lat) { b = it >> 8; c = (it & 255) >> 2; h = it & 3; row0 = (size_t)b * SEQ + c * 64; cidx = c; }
        else { const int j = it - 2048; b = j >> 4; c = (j & 15) >> 2; h = j & 3; row0 = (size_t)ML + b * CTXL + c * 64; cidx = 64 + c; }
        { const int r = tid >> 3, c4 = tid & 7; *(LAS f32x4*)(lds + A_DD + r * 128 + c4 * 16) = *(const f32x4*)(dd + (row0 + r) * 32 + 4 * c4); }
#pragma unroll
        for (int i = 0; i < 2; ++i) { const int pc = tid + 512 * i, r = pc >> 4, cp = pc & 15;
            *(LAS u32x4*)(lds + A_KR + r * A_RS + cp * 16) = *(const u32x4*)(kb + (row0 + r) * 512 + h * 128 + 8 * cp);
            if (lat) *(LAS u32x4*)(lds + A_QR + r * A_RS + cp * 16) = *(const u32x4*)(qb + (row0 + r) * 512 + h * 128 + 8 * cp); }
        const int ch = tid & 127, dir = (tid >> 7) & 1, half = tid >> 8;
        float w[16];
#pragma unroll
        for (int r = 0; r < 16; ++r) w[r] = p.w_dec_up[(size_t)(dir * 16 + r) * 512 + h * 128 + ch];
        const float bias = p.b_dec[dir * 512 + h * 128 + ch];
        __syncthreads();
        float la[32]; float tot = 0.f;
#pragma unroll
        for (int i = 0; i < 32; ++i) { const int t = half * 32 + i; const LAS f32x4* dp = (const LAS f32x4*)(lds + A_DD + t * 128 + dir * 64);
            float z = bias;
#pragma unroll
            for (int q4 = 0; q4 < 4; ++q4) { const f32x4 d = dp[q4];
#pragma unroll
                for (int j = 0; j < 4; ++j) z += d[j] * w[4 * q4 + j]; }
            const float l = (fminf(z, 0.f) - __logf(1.f + __expf(-fabsf(z)))) * (1.f / 16.f);
            la[i] = l; tot += l; }
        ((LAS float*)(lds + A_HT))[(dir * 2 + half) * 128 + ch] = tot;
        __syncthreads();
        { const float h0 = ((LAS float*)(lds + A_HT))[(dir * 2 + 0) * 128 + ch], h1 = ((LAS float*)(lds + A_HT))[(dir * 2 + 1) * 128 + ch];
            const float blast = h0 + h1;
            bf16_t* q2g = Q2 + ((size_t)dir * ML + (lat ? row0 : 0)) * 512 + h * 128 + ch;
            bf16_t* k2g = K2T + ((((size_t)dir * 8 + b) * 4 + h) * NCH + cidx) * 8192 + ch * 64 + half * 32;
            if (dir == 0) gla_pass2<0>(lds, la, ch, half, lat, h0, blast, half ? h0 : 0.f, q2g, k2g);
            else gla_pass2<1>(lds, la, ch, half, lat, h1, blast, half ? 0.f : h1, q2g, k2g);
            if (half == 0) dec[((((size_t)dir * 8 + b) * 4 + h) * NCH + cidx) * 128 + ch] = __expf(blast); }
        __syncthreads();
#pragma unroll
        for (int i = 0; i < 4; ++i) { const int t = lane, cp = wid + 8 * i;
            const u32x4 vv = *(const u32x4*)(vb + (row0 + t) * 1024 + h * 256 + 8 * cp);
#pragma unroll
            for (int e = 0; e < 4; ++e) { *(LAS bf16_t*)(lds + A_VT + (8 * cp + 2 * e) * A_PS + t * 2) = (bf16_t)(vv[e] & 0xffffu); *(LAS bf16_t*)(lds + A_VT + (8 * cp + 2 * e + 1) * A_PS + t * 2) = (bf16_t)(vv[e] >> 16); } }
        if (lat) {
            const int rt = wid >> 1, ct0 = (wid & 1) * 2;
            f32x4 ps[2] = {{0.f, 0.f, 0.f, 0.f}, {0.f, 0.f, 0.f, 0.f}};
#pragma unroll
            for (int d = 0; d < 2; ++d)
#pragma unroll
                for (int cc = 0; cc < 2; ++cc) { const int ct = ct0 + cc; f32x4 a = {0.f, 0.f, 0.f, 0.f};
#pragma unroll
                    for (int ks = 0; ks < 4; ++ks) { const bf16x8 af = *(const LAS bf16x8*)(lds + A_QD + d * 17408 + (16 * rt + fr) * A_RS + (32 * ks + 8 * fq) * 2), bfr = *(const LAS bf16x8*)(lds + A_KD + d * 17408 + (16 * ct + fr) * A_RS + (32 * ks + 8 * fq) * 2);
                        a = __builtin_amdgcn_mfma_f32_16x16x32_bf16(af, bfr, a, 0, 0, 0); }
#pragma unroll
                    for (int r = 0; r < 4; ++r) { const int i = 16 * rt + 4 * fq + r, j = 16 * ct + fr; const bool keep = d == 0 ? (i >= j) : (j >= i); ps[cc][r] += keep ? a[r] : 0.f; } }
#pragma unroll
            for (int cc = 0; cc < 2; ++cc)
#pragma unroll
                for (int r = 0; r < 4; ++r) *(LAS bf16_t*)(lds + A_P + (16 * rt + 4 * fq + r) * A_PS + (16 * (ct0 + cc) + fr) * 2) = f2bf(ps[cc][r]);
        }
        __syncthreads();
        { bf16_t* vtg = VT + (((size_t)b * 4 + h) * NCH + cidx) * 16384;
#pragma unroll
            for (int i = 0; i < 4; ++i) { const int pc = tid + 512 * i, vc = pc >> 3, tp = pc & 7; *(u32x4*)(vtg + vc * 64 + tp * 8) = *(const LAS u32x4*)(lds + A_VT + vc * A_PS + tp * 16); } }
        if (lat) {
#pragma unroll
            for (int vv = 0; vv < 2; ++vv) { const int vct = 2 * wid + vv;
#pragma unroll
                for (int rt = 0; rt < 4; ++rt) { f32x4 a = {0.f, 0.f, 0.f, 0.f};
#pragma unroll
                    for (int ks = 0; ks < 2; ++ks) { const bf16x8 af = *(const LAS bf16x8*)(lds + A_VT + (16 * vct + fr) * A_PS + (32 * ks + 8 * fq) * 2), bfr = *(const LAS bf16x8*)(lds + A_P + (16 * rt + fr) * A_PS + (32 * ks + 8 * fq) * 2);
                        a = __builtin_amdgcn_mfma_f32_16x16x32_bf16(af, bfr, a, 0, 0, 0); }
                    u32x2 w; w.x = pk_bf16(a[0], a[1]); w.y = pk_bf16(a[2], a[3]);
                    *(u32x2*)(vb + (row0 + 16 * rt + fr) * 1024 + h * 256 + 16 * vct + 4 * fq) = w; } }
        }
        __syncthreads();
    }
}

constexpr int B_ST = 0, B_STS = 272;
__device__ void phase_gla_b(const Params& p, LAS unsigned char* lds) {
    const int tid = threadIdx.x, lane = tid & 63, wid = __builtin_amdgcn_readfirstlane(tid >> 6), fr = lane & 15, fq = lane >> 4;
    const bf16_t* Q2 = (const bf16_t*)(p.ws + OFF_CB); const bf16_t* K2T = (const bf16_t*)p.out; const bf16_t* VT = (const bf16_t*)(p.ws + OFF_GB); const float* dec = (const float*)(p.ws + OFF_DEC);
    bf16_t* of = (bf16_t*)(p.ws + OFF_Q); bf16_t* vb = (bf16_t*)(p.ws + OFF_V);
    const int kt0 = (wid >> 1) * 2, ct0 = (wid & 1) * 2, rt = wid & 3, vct0 = (wid >> 2) * 2;
    for (int it = blockIdx.x; it < 256; it += gridDim.x) {
        const int grp = (it & 7) * 8 + ((it >> 3) >> 2), vs = (it >> 3) & 3, b = grp >> 3, h = (grp >> 1) & 3, dir = grp & 1;
        const bf16_t* k2b = K2T + ((((size_t)dir * 8 + b) * 4 + h) * NCH) * 8192;
        const bf16_t* vtb = VT + (((size_t)b * 4 + h) * NCH) * 16384 + (size_t)vs * 64 * 64;
        const float* dcb = dec + ((((size_t)dir * 8 + b) * 4 + h) * NCH) * 128;
        const bf16_t* q2b = Q2 + ((size_t)dir * ML + (size_t)b * SEQ) * 512 + h * 128;
        f32x4 S[2][2];
#pragma unroll
        for (int i = 0; i < 2; ++i)
#pragma unroll
            for (int j = 0; j < 2; ++j) S[i][j] = (f32x4){0.f, 0.f, 0.f, 0.f};
        bf16x8 kf[2][2], vf[2][2], nkf[2][2], nvf[2][2], qf[4]; f32x4 df[2], ndf[2];
#define GB_CIDX(n) (dir == 0 ? ((n) < 4 ? 64 + (n) : (n) - 4) : ((n) < 4 ? 67 - (n) : 67 - (n)))
#define GB_LOAD(KF, VF, DF, ci) do { _Pragma("unroll") for (int i = 0; i < 2; ++i) { _Pragma("unroll") for (int ks = 0; ks < 2; ++ks) { \
            KF[i][ks] = *(const bf16x8*)(k2b + (size_t)(ci) * 8192 + (16 * (kt0 + i) + fr) * 64 + 32 * ks + 8 * fq); \
            VF[i][ks] = *(const bf16x8*)(vtb + (size_t)(ci) * 16384 + (16 * (ct0 + i) + fr) * 64 + 32 * ks + 8 * fq); } \
            DF[i] = *(const f32x4*)(dcb + (size_t)(ci) * 128 + 16 * (kt0 + i) + 4 * fq); } } while (0)
        { const int c0i = dir == 0 ? 64 : 67; GB_LOAD(kf, vf, df, c0i); }
#pragma unroll 1
        for (int n = 0; n < NCH; ++n) {
            const bool lat = n >= 4; const int cl = dir == 0 ? n - 4 : 67 - n;
            if (lat) {
#pragma unroll
                for (int ks = 0; ks < 4; ++ks) qf[ks] = *(const bf16x8*)(q2b + (size_t)(cl * 64 + 16 * rt + fr) * 512 + 32 * ks + 8 * fq); }
            { const int nn = n + 1 < NCH ? n + 1 : n; const int ci = dir == 0 ? (nn < 4 ? 64 + nn : nn - 4) : 67 - nn; GB_LOAD(nkf, nvf, ndf, ci); }
            LAS unsigned char* st = lds + B_ST + (n & 1) * 17408;
            if (lat) {
#pragma unroll
                for (int i = 0; i < 2; ++i)
#pragma unroll
                    for (int j = 0; j < 2; ++j) { u32x2 w; w.x = pk_bf16(S[i][j][0], S[i][j][1]); w.y = pk_bf16(S[i][j][2], S[i][j][3]);
                        *(LAS u32x2*)(st + (16 * (ct0 + j) + fr) * B_STS + (16 * (kt0 + i) + 4 * fq) * 2) = w; } }
            __syncthreads();
#pragma unroll
            for (int i = 0; i < 2; ++i)
#pragma unroll
                for (int j = 0; j < 2; ++j) { S[i][j] = S[i][j] * df[i];
#pragma unroll
                    for (int ks = 0; ks < 2; ++ks) S[i][j] = __builtin_amdgcn_mfma_f32_16x16x32_bf16(kf[i][ks], vf[j][ks], S[i][j], 0, 0, 0); }
            if (lat) {
#pragma unroll
                for (int jj = 0; jj < 2; ++jj) { f32x4 a = {0.f, 0.f, 0.f, 0.f};
#pragma unroll
                    for (int ks = 0; ks < 4; ++ks) { const bf16x8 af = *(const LAS bf16x8*)(st + (16 * (vct0 + jj) + fr) * B_STS + (32 * ks + 8 * fq) * 2);
                        a = __builtin_amdgcn_mfma_f32_16x16x32_bf16(af, qf[ks], a, 0, 0, 0); }
                    const size_t off = ((size_t)b * SEQ + cl * 64 + 16 * rt + fr) * 1024 + h * 256 + vs * 64 + 16 * (vct0 + jj) + 4 * fq;
                    if (dir == 0) { u32x2 w; w.x = pk_bf16(a[0], a[1]); w.y = pk_bf16(a[2], a[3]); *(u32x2*)(of + off) = w; }
                    else { const u32x2 o = *(const u32x2*)(vb + off); u32x2 w; w.x = pk_bf16(a[0] + bf_lo(o.x), a[1] + bf_hi(o.x)); w.y = pk_bf16(a[2] + bf_lo(o.y), a[3] + bf_hi(o.y)); *(u32x2*)(vb + off) = w; } }
            }
#pragma unroll
            for (int i = 0; i < 2; ++i) { df[i] = ndf[i];
#pragma unroll
                for (int ks = 0; ks < 2; ++ks) { kf[i][ks] = nkf[i][ks]; vf[i][ks] = nvf[i][ks]; } }
        }
        __syncthreads();
#undef GB_LOAD
#undef GB_CIDX
    }
}

__device__ void phase_agla(const Params& p) {
    const int lane = threadIdx.x & 63, wid = threadIdx.x >> 6;
    const bf16_t* o1 = (const bf16_t*)(p.ws + OFF_V); const bf16_t* o2 = (const bf16_t*)(p.ws + OFF_Q); bf16_t* g = (bf16_t*)(p.ws + OFF_G);
    const f32x4 gh = *(const f32x4*)(p.g_head + 4 * lane);
    for (int idx = blockIdx.x * 8 + wid; idx < ML * 4; idx += gridDim.x * 8) {
        const size_t off = (size_t)(idx >> 2) * 1024 + (idx & 3) * 256 + 4 * lane;
        const u32x2 a = *(const u32x2*)(o1 + off), b = *(const u32x2*)(o2 + off), gs = *(const u32x2*)(g + off);
        float o[4] = {bf_lo(a.x) + bf_lo(b.x), bf_hi(a.x) + bf_hi(b.x), bf_lo(a.y) + bf_lo(b.y), bf_hi(a.y) + bf_hi(b.y)};
        float ss = o[0] * o[0] + o[1] * o[1] + o[2] * o[2] + o[3] * o[3];
        ss = wave_sum(ss);
        const float rs = rsqrtf(ss * (1.f / 256.f) + 1e-6f);
        const float gg[4] = {bf_lo(gs.x), bf_hi(gs.x), bf_lo(gs.y), bf_hi(gs.y)};
        u32x2 w; w.x = pk_bf16(o[0] * rs * gh[0] * gg[0], o[1] * rs * gh[1] * gg[1]); w.y = pk_bf16(o[2] * rs * gh[2] * gg[2], o[3] * rs * gh[3] * gg[3]);
        *(u32x2*)(g + off) = w;
    }
}

__device__ __forceinline__ void run_phase(const Params& p, LAS unsigned char* lds, int ph) {
    unsigned char* ws = p.ws; const float* mod = (const float*)(ws + OFF_MOD);
    const int G = (int)gridDim.x, c = (int)blockIdx.x;
    switch (ph) {
    case 0: phase_prep(p, lds); break;
    case 1: norm_mod_rows(p.x, p.ctx, ML, MT, (bf16_t*)p.out, p.g_mix, mod, 0, 1024); break;
    case 2: { pg8::Gemm g{(const bf16_t*)p.out, (const bf16_t*)(ws + OFF_WIN), MT, NINP, 1024}; pg8::InOrder S; S.init(G, c);
        EpiInProj E{(bf16_t*)(ws + OFF_Q), (bf16_t*)(ws + OFF_K), (bf16_t*)(ws + OFF_V), (bf16_t*)(ws + OFF_G), (bf16_t*)(ws + OFF_CB), (bf16_t*)(ws + OFF_U), (bf16_t*)(ws + OFF_GA), (bf16_t*)(ws + OFF_GB), (float*)(ws + OFF_DD)};
        pg8::gemm_phase(lds, g, S, E); } break;
    case 3: phase_conv(p); break;
    case 4: { pg8::Gemm g{(const bf16_t*)(ws + OFF_CB), (const bf16_t*)(ws + OFF_WCONV), ML, 1024, 1024}; pg8::StaticOrder S; S.init(ML, 1024, G, c);
        EpiGate<0> E{(bf16_t*)(ws + OFF_U), (const bf16_t*)(ws + OFF_GB)}; pg8::gemm_phase(lds, g, S, E); } break;
    case 5: phase_gla_a(p, lds); break;
    case 6: phase_gla_b(p, lds); break;
    case 7: phase_agla(p); break;
    case 8: { pg8::Gemm g{(const bf16_t*)(ws + OFF_G), (const bf16_t*)(ws + OFF_WGLA), ML, 1024, 1024}; pg8::StaticOrder S; S.init(ML, 1024, G, c);
        EpiGate<1> E{(bf16_t*)(ws + OFF_U), (const bf16_t*)(ws + OFF_GA)}; pg8::gemm_phase(lds, g, S, E); } break;
    case 9: { pg8::Gemm g{(const bf16_t*)(ws + OFF_U), (const bf16_t*)(ws + OFF_WMIX), ML, 1024, 1024}; pg8::StaticOrder S; S.init(ML, 1024, G, c);
        EpiRes E{p.x, p.out, mod + 2048}; pg8::gemm_phase(lds, g, S, E); } break;
    case 10: norm_mod_rows(p.out, p.out, ML, ML, (bf16_t*)(ws + OFF_G), p.g_ffn, mod, 3072, 4096); break;
    case 11: { pg8::Gemm g{(const bf16_t*)(ws + OFF_G), (const bf16_t*)(ws + OFF_WFFI), ML, 2 * DFF, 1024}; pg8::StaticOrder S; S.init(ML, 2 * DFF, G, c);
        EpiFfnIn E{(bf16_t*)(ws + OFF_GA)}; pg8::gemm_phase(lds, g, S, E); } break;
    case 12: { pg8::Gemm g{(const bf16_t*)(ws + OFF_GA), (const bf16_t*)(ws + OFF_WFFO), ML, 1024, DFF}; pg8::StaticOrder S; S.init(ML, 1024, G, c);
        EpiRes E{p.out, p.out, mod + 5120}; pg8::gemm_phase(lds, g, S, E); } break;
    case 13: phase_final(p); break;
    default: break;
    }
}

#if FUSED
__global__ void __launch_bounds__(512, 2) mega_fwd(Params p) {
    extern __shared__ __attribute__((aligned(16))) unsigned char shm[];
    LAS unsigned char* lds = (LAS unsigned char*)shm;
    cg::grid_group grid = cg::this_grid();
#define PH(n) run_phase(p, lds, n); asm volatile("" ::: "memory"); grid.sync(); asm volatile("" ::: "memory");
    PH(0) PH(1) PH(2) PH(3) PH(4) PH(5) PH(6) PH(7) PH(8) PH(9) PH(10) PH(11) PH(12)
    run_phase(p, lds, 13);
#undef PH
}
#else
__global__ void __launch_bounds__(512, 2) mega_fwd(Params p, int ph) {
    extern __shared__ __attribute__((aligned(16))) unsigned char shm[];
    LAS unsigned char* lds = (LAS unsigned char*)shm;
    run_phase(p, lds, ph);
}
#endif

extern "C" void kernel_launch(void* const* d_in, const int* in_sizes, int n_in, void* d_out, int out_size, void* d_ws, size_t ws_size, hipStream_t stream) {
    static int grid = 0;
    if (grid == 0) {
        if (n_in != 19 || out_size != ML * DM || ws_size < WS_NEED) { fprintf(stderr, "kernel_launch: unexpected shapes (n_in %d out %d ws %zu need %zu)\n", n_in, out_size, ws_size, (size_t)WS_NEED); grid = -1; return; }
        int dev = 0, cus = 0, per_cu = 0;
        (void)hipGetDevice(&dev); (void)hipDeviceGetAttribute(&cus, hipDeviceAttributeMultiprocessorCount, dev);
        if (hipFuncSetAttribute((const void*)mega_fwd, hipFuncAttributeMaxDynamicSharedMemorySize, LDS_BYTES) != hipSuccess) { fprintf(stderr, "hipFuncSetAttribute failed\n"); grid = -1; return; }
        if (hipOccupancyMaxActiveBlocksPerMultiprocessor(&per_cu, (const void*)mega_fwd, 512, LDS_BYTES) != hipSuccess || per_cu < 1) { fprintf(stderr, "occupancy query failed (%d)\n", per_cu); (void)hipGetLastError(); per_cu = 1; }
        if (per_cu > 1) per_cu = 1;
        grid = cus * per_cu;
    }
    if (grid < 0) return;
    Params p{};
    const float** f = (const float**)&p;
    for (int i = 0; i < 19; ++i) f[i] = (const float*)d_in[i];
    p.out = (float*)d_out; p.ws = (unsigned char*)d_ws;
#if FUSED
    void* args[] = {&p};
    hipError_t e = hipLaunchCooperativeKernel((const void*)mega_fwd, dim3(grid), dim3(512), args, LDS_BYTES, stream);
    if (e != hipSuccess) fprintf(stderr, "cooperative launch failed: %s (grid %d)\n", hipGetErrorString(e), grid);
#else
    for (int ph = 0; ph < NPHASE; ++ph) hipLaunchKernelGGL(mega_fwd, dim3(grid), dim3(512), LDS_BYTES, stream, p, ph);
#endif
}
```

```cpp
#include <hip/hip_runtime.h>
#include <hip/hip_cooperative_groups.h>
#include <cstdio>
namespace cg = cooperative_groups;

#ifndef FUSED
#define FUSED 1
#endif

#define LAS __attribute__((address_space(3)))
typedef unsigned short bf16_t;
typedef short bf16x8 __attribute__((ext_vector_type(8)));
typedef float f32x4 __attribute__((ext_vector_type(4)));
typedef unsigned u32x4 __attribute__((ext_vector_type(4)));
typedef unsigned u32x2 __attribute__((ext_vector_type(2)));

constexpr int DM = 1024, NB = 8, SEQ = 4096, CTXL = 256;
constexpr int ML = NB * SEQ, MC = NB * CTXL, MT = ML + MC;
constexpr int DFF = 2816, NIN = 8224, NINP = 8448, NCH = 68;
constexpr int LDS_STAGE = 131072;
constexpr int LDS_BYTES = LDS_STAGE + 16;
constexpr int NPHASE = 14;

constexpr size_t OFF_WIN = 0;
constexpr size_t OFF_WGLA = OFF_WIN + (size_t)NINP * 1024 * 2;
constexpr size_t OFF_WCONV = OFF_WGLA + 2097152;
constexpr size_t OFF_WMIX = OFF_WCONV + 2097152;
constexpr size_t OFF_WFFI = OFF_WMIX + 2097152;
constexpr size_t OFF_WFFO = OFF_WFFI + (size_t)5632 * 1024 * 2;
constexpr size_t OFF_MOD = OFF_WFFO + (size_t)1024 * 2816 * 2;
constexpr size_t OFF_DEC = OFF_MOD + (size_t)9 * 6144 * 4;
constexpr size_t OFF_DD = OFF_DEC + (size_t)2 * 8 * 4 * NCH * 384 * 4;
constexpr size_t OFF_Q = OFF_DD + (size_t)MT * 32 * 4;
constexpr size_t OFF_K = OFF_Q + (size_t)ML * 512 * 2;
constexpr size_t OFF_V = OFF_K + (size_t)MT * 512 * 2;
constexpr size_t OFF_G = OFF_V + (size_t)MT * 1024 * 2;
constexpr size_t OFF_GA = OFF_G + (size_t)ML * 1024 * 2;
constexpr size_t OFF_U = OFF_GA + (size_t)ML * 1024 * 2;
constexpr size_t OFF_CB = OFF_U + (size_t)ML * 1024 * 2;
constexpr size_t OFF_GB = OFF_CB + (size_t)ML * 1024 * 2;
constexpr size_t OFF_BAR = OFF_GB + (size_t)NB * 4 * NCH * 256 * 64 * 2;
constexpr size_t BAR_BYTES = 16384;
constexpr size_t WS_NEED = OFF_BAR + BAR_BYTES;
constexpr size_t OFF_ROWSS = OFF_DD;
constexpr size_t OFF_BIAS2 = OFF_DD + 262144;

struct Params {
    const float *x, *c, *ctx, *c_ctx, *w_ada, *b_ada, *g_mix, *w_in, *w_dec_up, *b_dec, *g_head, *w_gla_out, *w_conv, *w_conv_out,
        *w_mix_out, *g_ffn, *w_ffn_in, *w_ffn_out, *g_final;
    float* out;
    unsigned char* ws;
};

typedef __bf16 bf16v2_t __attribute__((ext_vector_type(2)));
typedef float f32x2_t __attribute__((ext_vector_type(2)));
__device__ __forceinline__ unsigned pk_bf16(float lo, float hi) { const f32x2_t v = {lo, hi}; const bf16v2_t b = __builtin_convertvector(v, bf16v2_t); return __builtin_bit_cast(unsigned, b); }
__device__ __forceinline__ float bf_lo(unsigned w) { return __uint_as_float(w << 16); }
__device__ __forceinline__ float bf_hi(unsigned w) { return __uint_as_float(w & 0xffff0000u); }
__device__ __forceinline__ float bf2f(bf16_t b) { return __uint_as_float(((unsigned)b) << 16); }
__device__ __forceinline__ bf16_t f2bf(float f) { return (bf16_t)(pk_bf16(f, 0.f) & 0xffffu); }
__device__ __forceinline__ float wave_sum(float v) {
#pragma unroll
    for (int o = 32; o > 0; o >>= 1) v += __shfl_xor(v, o);
    return v;
}
__device__ __forceinline__ float sigmoidf_(float v) { return __builtin_amdgcn_rcpf(1.f + __expf(-v)); }


#define XB_TMO      128
#define XB_XCNT(j)  (256  + 64 * (j))
#define XB_XSUB(j)  (1280 + 64 * (j))
#define XB_XGEN(j)  (2304 + 64 * (j))
#define XB_TOP      3328
#define XB_TOPGEN   3392
#define XCD_BAR_WORDS 3456
#define XB_SPIN_CAP (1u << 18)
__device__ __forceinline__ unsigned xb_ld(unsigned* p)              { return __hip_atomic_load(p, __ATOMIC_RELAXED, __HIP_MEMORY_SCOPE_AGENT); }
__device__ __forceinline__ unsigned xb_add(unsigned* p, unsigned v) { return __hip_atomic_fetch_add(p, v, __ATOMIC_RELAXED, __HIP_MEMORY_SCOPE_AGENT); }
__device__ __forceinline__ unsigned xb_xcc_id() { return (unsigned)__builtin_amdgcn_s_getreg((3 << 11) | 20) & 0xFu; }
#define XB_SPIN(cond, bar) do { unsigned _sp = 0; while (cond) { __builtin_amdgcn_s_sleep(1); \
    if ((++_sp & 255u) == 0u) { if (xb_ld(&(bar)[XB_TMO])) break; if (_sp > XB_SPIN_CAP) { atomicAdd(&(bar)[XB_TMO], 1u); break; } } } } while (0)
struct XcdBarrier { unsigned* bar; unsigned x; volatile LAS unsigned* st; };
__device__ __forceinline__ XcdBarrier xcd_barrier_post(unsigned* bar, volatile LAS unsigned* st) {
    XcdBarrier b; b.bar = bar; b.x = xb_xcc_id(); b.st = st;
    if (threadIdx.x == 0) (void)xb_add(&bar[XB_XCNT(b.x)], 1u);
    return b;
}
__device__ __forceinline__ void xcd_barrier_complete(unsigned* bar, unsigned x, unsigned& nloc, unsigned& nx) {
    const unsigned G = gridDim.x * gridDim.y * gridDim.z;
    unsigned sum, cnt, mine, sp = 0u;
    for (;;) {
        sum = 0u; cnt = 0u; mine = 0u;
#pragma unroll
        for (unsigned j = 0; j < 16; ++j) { const unsigned c = xb_ld(&bar[XB_XCNT(j)]); sum += c; cnt += (c > 0u) ? 1u : 0u; mine = (j == x) ? c : mine; }
        if (sum == G) break;
        __builtin_amdgcn_s_sleep(1);
        if ((++sp & 255u) == 0u) { if (xb_ld(&bar[XB_TMO])) break; if (sp > XB_SPIN_CAP) { atomicAdd(&bar[XB_TMO], 1u); break; } }
    }
    nloc = mine > 0u ? mine : 1u; nx = cnt > 0u ? cnt : 1u;
}
__device__ __forceinline__ void xcd_barrier(const XcdBarrier& b) {
    asm volatile("s_waitcnt vmcnt(0)" ::: "memory");
    __syncthreads();
    if (threadIdx.x == 0) {
        unsigned* bar = b.bar;
        __builtin_amdgcn_s_waitcnt(0);
        unsigned nloc = b.st[0], nx = b.st[1];
        if (nloc == 0u) { xcd_barrier_complete(bar, b.x, nloc, nx); b.st[0] = nloc; b.st[1] = nx; }
        const unsigned old = xb_add(&bar[XB_XSUB(b.x)], 1u);
        const unsigned gen = old / nloc;
        if (old + 1u == (gen + 1u) * nloc) {
            __builtin_amdgcn_fence(__ATOMIC_RELEASE, "agent");
            asm volatile("s_waitcnt vmcnt(0)" ::: "memory");
            const unsigned og = xb_add(&bar[XB_TOP], 1u);
            const unsigned tg = og / nx;
            if (og + 1u == (tg + 1u) * nx) xb_add(&bar[XB_TOPGEN], 1u);
            else XB_SPIN(xb_ld(&bar[XB_TOPGEN]) == tg, bar);
            __builtin_amdgcn_fence(__ATOMIC_ACQUIRE, "agent");
            xb_add(&bar[XB_XGEN(b.x)], 1u);
            asm volatile("s_waitcnt vmcnt(0)" ::: "memory");
        } else {
            XB_SPIN(xb_ld(&bar[XB_XGEN(b.x)]) == gen, bar);
            __builtin_amdgcn_fence(__ATOMIC_ACQUIRE, "agent");
            asm volatile("s_waitcnt vmcnt(0)" ::: "memory");
        }
    }
    __syncthreads();
}

namespace pg8 {
constexpr int BM = 256, BK = 64, HALF = 128, HTB = HALF * BK * 2, NXCD = 8, WGM = 2;
__device__ __forceinline__ int lds_byte(int r, int c) { const int st = (r >> 4) * 2 + (c >> 5), rr = r & 15, cc = c & 31, ob = rr * 64 + cc * 2; return st * 1024 + (ob ^ (((ob >> 9) & 1) << 5)); }
__device__ __forceinline__ void stage_rc(int b, int& R, int& C) { const int st = b / 1024, sb = b % 1024, swz = sb ^ (((sb >> 9) & 1) << 5); R = (st >> 1) * 16 + swz / 64; C = (st & 1) * 32 + (swz % 64) / 2; }
__device__ __forceinline__ int perm32(int rho) { const int n = rho >> 4, i = rho & 15; return 8 * (i >> 2) + 4 * n + (i & 3); }
struct Unit { int pm, pn, kind; };
struct Gemm { const bf16_t* A; const bf16_t* Bt; int M, N, K, nt; };

struct StaticOrder {
    int nM, nN, nwg, G, c;
    __device__ void init(int M, int N, int G_, int c_) { nM = M / BM; nN = N / BM; nwg = nM * nN; G = G_; c = c_; }
    __device__ bool next(int i, Unit& u) const {
        const long L = (long)i * G + c; if (L >= nwg) return false;
        int wgid = (int)L; { const int q = nwg / NXCD, r = nwg % NXCD, xcd = wgid % NXCD, off = wgid / NXCD; wgid = (xcd < r ? xcd * (q + 1) : r * (q + 1) + (xcd - r) * q) + off; }
        const int nig = WGM * nN, gid = wgid / nig, fm = gid * WGM, gsz = (nM - fm) < WGM ? (nM - fm) : WGM;
        u.pm = fm + ((wgid % nig) % gsz); u.pn = (wgid % nig) / gsz; u.kind = 0; return true;
    }
};
struct DualOrder {
    StaticOrder so;
    __device__ void init(int M, int N, int G_, int c_) { so.init(M, N, G_, c_); }
    __device__ bool next(int i, Unit& u) const { if (!so.next(i >> 1, u)) return false; u.kind = i & 1; return true; }
};
struct InOrder {
    StaticOrder so;
    __device__ void init(int G_, int c_) { so.init(ML, NINP, G_, c_); }
    __device__ bool next(int i, Unit& u) const {
        const long L = (long)i * so.G + so.c;
        if (L < so.nwg) return so.next(i, u);
        const int j = (int)(L - so.nwg); if (j >= 56) return false;
        u.pm = 128 + j / 7; const int cc = j % 7; u.pn = cc < 2 ? 2 + cc : (cc < 6 ? 4 + (cc - 2) : 32); u.kind = 0; return true;
    }
};

template <class Epi, class Sched>
__device__ __forceinline__ void gemm_phase(LAS unsigned char* lds, const Gemm g, const Sched& S, const Epi& E) {
    const int tid = threadIdx.x, wid = __builtin_amdgcn_readfirstlane(tid >> 6), lane = tid & 63, wr = wid >> 2, wc = wid & 3, fr = lane & 15, fq = lane >> 4;
    const int K = g.K, nt = g.nt;
    unsigned voffA[2], voffB[2];
#pragma unroll
    for (int i = 0; i < 2; ++i) { int R, C; stage_rc(tid * 16 + i * 8192, R, C); const int Rb = Epi::PERM ? ((R & ~31) + perm32(R & 31)) : R;
        voffA[i] = (unsigned)(R * K + C) * 2u; voffB[i] = (unsigned)(Rb * K + C) * 2u; }
    const size_t kstep = (size_t)(BK * 2);
    const size_t hstep = (size_t)HALF * K * 2;
    const size_t tstep = 2 * hstep;
    const unsigned ldsw = (unsigned)wid * 1024u;
    const int aoff = lds_byte(wr * 64 + fr, fq * 8), boff = lds_byte(wc * 32 + fr, fq * 8);
#define PG8_SA(b, h) (((b) * 2 + (h)) * HTB)
#define PG8_SB(b, h) ((4 + (b) * 2 + (h)) * HTB)
#define PG8_STAGE(bufoff, gbase, voff) do { _Pragma("unroll") for (int _i = 0; _i < 2; ++_i) \
        __builtin_amdgcn_global_load_lds((const unsigned*)((const char*)(gbase) + (voff)[_i]), (LAS unsigned*)(lds + (bufoff) + ldsw + _i * 8192), 16, 0, 0); } while (0)
#define PG8_LDA(dst, b, h) do { _Pragma("unroll") for (int m = 0; m < 4; ++m) _Pragma("unroll") for (int k = 0; k < 2; ++k) dst[m][k] = *(const LAS bf16x8*)(lds + PG8_SA(b, h) + aoff + m * 2048 + k * 1024); } while (0)
#define PG8_LDB(dst, b, h) do { _Pragma("unroll") for (int n = 0; n < 2; ++n) _Pragma("unroll") for (int k = 0; k < 2; ++k) dst[n][k] = *(const LAS bf16x8*)(lds + PG8_SB(b, h) + boff + n * 2048 + k * 1024); } while (0)
#define PG8_MMA(ai, bj, At, Bt) do { __builtin_amdgcn_s_setprio(1); _Pragma("unroll") for (int m = 0; m < 4; ++m) _Pragma("unroll") for (int n = 0; n < 2; ++n) _Pragma("unroll") for (int k = 0; k < 2; ++k) \
        acc[ai][bj][m][n] = __builtin_amdgcn_mfma_f32_16x16x32_bf16(Bt[n][k], At[m][k], acc[ai][bj][m][n], 0, 0, 0); __builtin_amdgcn_s_setprio(0); } while (0)
#define PG8_WAIT_V(n) asm volatile("s_waitcnt vmcnt(" #n ")" ::: "memory")
#define PG8_WAIT_L(n) asm volatile("s_waitcnt lgkmcnt(" #n ")" ::: "memory")
#define PG8_BAR __builtin_amdgcn_s_barrier()
#define PG8_SCHED __builtin_amdgcn_sched_barrier(0)
    Unit cur, nxt; int ui = 0;
    if (!S.next(0, cur)) return;
    f32x4 acc[2][2][4][2];
#pragma unroll
    for (int a = 0; a < 2; ++a)
#pragma unroll
        for (int b = 0; b < 2; ++b)
#pragma unroll
            for (int m = 0; m < 4; ++m)
#pragma unroll
                for (int n = 0; n < 2; ++n) acc[a][b][m][n] = (f32x4){0.f, 0.f, 0.f, 0.f};
    bf16x8 At[4][2], B0[2][2], B1[2][2];
#define PG8_UA(u) ((const char*)g.A + (size_t)(u).pm * tstep + ((Epi::DUAL && (u).kind) ? Epi::DA2 : 0l))
#define PG8_UB(u) ((const char*)g.Bt + (size_t)(u).pn * tstep + ((Epi::DUAL && (u).kind) ? Epi::DB2 : 0l))
    const char* cA = PG8_UA(cur); const char* cB = PG8_UB(cur);
    PG8_STAGE(PG8_SB(0, 0), cB, voffB); PG8_STAGE(PG8_SA(0, 0), cA, voffA); PG8_STAGE(PG8_SB(0, 1), cB + hstep, voffB); PG8_STAGE(PG8_SA(0, 1), cA + hstep, voffA);
    if (wr == 1) PG8_BAR;
    PG8_WAIT_V(4); PG8_BAR;
    PG8_STAGE(PG8_SB(1, 0), cB + kstep, voffB); PG8_STAGE(PG8_SA(1, 0), cA + kstep, voffA); PG8_STAGE(PG8_SB(1, 1), cB + hstep + kstep, voffB);
    PG8_WAIT_V(6); PG8_BAR;
    for (;;) {
        const bool has_next = S.next(ui + 1, nxt);
        const char* nA = has_next ? PG8_UA(nxt) : cA; const char* nB = has_next ? PG8_UB(nxt) : cB;
#define PG8_ITER(t) do { \
            const bool last = (t == nt - 2); \
            const char* a1 = cA + (size_t)(t + 1) * kstep; \
            const char* a2 = last ? nA : cA + (size_t)(t + 2) * kstep; \
            const char* b2 = last ? nB : cB + (size_t)(t + 2) * kstep; \
            const char* a3 = a2 + kstep; const char* b3 = b2 + kstep; \
            PG8_LDB(B0, 0, 0); PG8_SCHED; PG8_LDA(At, 0, 0); PG8_STAGE(PG8_SA(1, 1), a1 + hstep, voffA); \
            PG8_WAIT_L(8); PG8_BAR; PG8_WAIT_L(0); PG8_MMA(0, 0, At, B0); PG8_BAR; PG8_SCHED; \
            PG8_LDB(B1, 0, 1); PG8_STAGE(PG8_SB(0, 0), b2, voffB); \
            PG8_BAR; PG8_WAIT_L(0); PG8_MMA(0, 1, At, B1); PG8_BAR; \
            PG8_LDA(At, 0, 1); PG8_STAGE(PG8_SA(0, 0), a2, voffA); \
            PG8_BAR; PG8_WAIT_L(0); PG8_MMA(1, 0, At, B0); PG8_BAR; PG8_SCHED; \
            PG8_STAGE(PG8_SB(0, 1), b2 + hstep, voffB); \
            PG8_WAIT_V(6); PG8_BAR; PG8_MMA(1, 1, At, B1); PG8_BAR; \
            PG8_LDB(B0, 1, 0); PG8_SCHED; PG8_LDA(At, 1, 0); PG8_STAGE(PG8_SA(0, 1), a2 + hstep, voffA); \
            PG8_WAIT_L(8); PG8_BAR; PG8_WAIT_L(0); PG8_MMA(0, 0, At, B0); PG8_BAR; PG8_SCHED; \
            PG8_LDB(B1, 1, 1); PG8_STAGE(PG8_SB(1, 0), b3, voffB); \
            PG8_BAR; PG8_WAIT_L(0); PG8_MMA(0, 1, At, B1); PG8_BAR; \
            PG8_LDA(At, 1, 1); PG8_STAGE(PG8_SA(1, 0), a3, voffA); \
            PG8_BAR; PG8_WAIT_L(0); PG8_MMA(1, 0, At, B0); PG8_BAR; PG8_SCHED; \
            PG8_STAGE(PG8_SB(1, 1), b3 + hstep, voffB); \
            PG8_WAIT_V(6); PG8_BAR; PG8_MMA(1, 1, At, B1); PG8_BAR; \
        } while (0)
        for (int t = 0; t < nt; t += 2) PG8_ITER(t);
#undef PG8_ITER
        bool keep = false;
        if constexpr (Epi::DUAL) keep = E(acc, cur, wr, wc, fr, fq); else E(acc, cur, wr, wc, fr, fq);
        if (!has_next) break;
        if (!keep) {
#pragma unroll
            for (int a = 0; a < 2; ++a)
#pragma unroll
                for (int b = 0; b < 2; ++b)
#pragma unroll
                    for (int m = 0; m < 4; ++m)
#pragma unroll
                        for (int n = 0; n < 2; ++n) acc[a][b][m][n] = (f32x4){0.f, 0.f, 0.f, 0.f};
        }
        cur = nxt; cA = nA; cB = nB; ++ui;
    }
    PG8_WAIT_V(0);
    if (wr == 0) PG8_BAR;
    PG8_BAR;
#undef PG8_UA
#undef PG8_UB
#undef PG8_SA
#undef PG8_SB
#undef PG8_STAGE
#undef PG8_LDA
#undef PG8_LDB
#undef PG8_MMA
#undef PG8_WAIT_V
#undef PG8_WAIT_L
#undef PG8_BAR
#undef PG8_SCHED
}
}
using pg8::Unit;

template <int CTRL> __device__ __forceinline__ float dpp_row(float v) { return __builtin_bit_cast(float, __builtin_amdgcn_update_dpp(0, __builtin_bit_cast(int, v), CTRL, 0xF, 0xF, false)); }
struct EpiInProj {
    static constexpr bool PERM = true, DUAL = false; static constexpr int NT1 = 0; static constexpr long DA2 = 0, DB2 = 0;
    bf16_t *q, *k, *v, *g, *aconv, *ga, *gb; float* dd; const float* wconv;
    __device__ __forceinline__ void operator()(const f32x4 (&acc)[2][2][4][2], const Unit& un, int wr, int wc, int fr, int fq) const {
        const int pn = un.pn; const size_t row0 = (size_t)un.pm * 256 + wr * 64 + fr;
        if (pn < 12 || (pn >= 28 && pn < 32)) {
            bf16_t* base; int ldc, colt, act;
            if (pn < 2) { base = q; ldc = 512; colt = pn * 256; act = 0; }
            else if (pn < 4) { base = k; ldc = 512; colt = (pn - 2) * 256; act = 0; }
            else if (pn < 8) { base = v; ldc = 1024; colt = (pn - 4) * 256; act = 0; }
            else if (pn < 12) { base = g; ldc = 1024; colt = (pn - 8) * 256; act = 1; }
            else { base = ga; ldc = 1024; colt = (pn - 28) * 256; act = 2; }
            const int col0 = colt + wc * 32 + 8 * fq;
#pragma unroll
            for (int ai = 0; ai < 2; ++ai)
#pragma unroll
                for (int m = 0; m < 4; ++m) { bf16_t* rowp = base + (row0 + ai * 128 + m * 16) * ldc + col0;
#pragma unroll
                    for (int bj = 0; bj < 2; ++bj) { f32x4 v0 = acc[ai][bj][m][0], v1 = acc[ai][bj][m][1];
                        if (act) {
#pragma unroll
                            for (int j = 0; j < 4; ++j) { const float s0 = sigmoidf_(v0[j]), s1 = sigmoidf_(v1[j]); v0[j] = act == 1 ? v0[j] * s0 : s0; v1[j] = act == 1 ? v1[j] * s1 : s1; } }
                        u32x4 w; w.x = pk_bf16(v0[0], v0[1]); w.y = pk_bf16(v0[2], v0[3]); w.z = pk_bf16(v1[0], v1[1]); w.w = pk_bf16(v1[2], v1[3]);
                        *(u32x4*)(rowp + bj * 128) = w; } }
        } else if (pn < 28) {
            const int chb = 64 * (pn - 12) + 16 * wc + 4 * fq;
            const f32x4 w0 = *(const f32x4*)(wconv + chb), w1 = *(const f32x4*)(wconv + 1024 + chb), w2 = *(const f32x4*)(wconv + 2048 + chb);
            const f32x4 zero = {0.f, 0.f, 0.f, 0.f};
#pragma unroll
            for (int ai = 0; ai < 2; ++ai) {
                f32x4 u[4], A[4], C[4];
#pragma unroll
                for (int m = 0; m < 4; ++m) { u[m] = acc[ai][0][m][1] * acc[ai][1][m][0];
#pragma unroll
                    for (int j = 0; j < 4; ++j) { A[m][j] = dpp_row<0x121>(u[m][j]); C[m][j] = dpp_row<0x12F>(u[m][j]); } }
#pragma unroll
                for (int m = 0; m < 4; ++m) {
                    const f32x4 prev = fr > 0 ? A[m] : (m > 0 ? A[m > 0 ? m - 1 : 0] : zero), next = fr < 15 ? C[m] : (m < 3 ? C[m < 3 ? m + 1 : 3] : zero);
                    const f32x4 uc = w0 * prev + w1 * u[m] + w2 * next, ac = acc[ai][0][m][0] * uc, gv = acc[ai][1][m][1];
                    const size_t off = (row0 + ai * 128 + m * 16) * 1024 + chb;
                    u32x2 wa; wa.x = pk_bf16(ac[0], ac[1]); wa.y = pk_bf16(ac[2], ac[3]); *(u32x2*)(aconv + off) = wa;
                    u32x2 wg; wg.x = pk_bf16(sigmoidf_(gv[0]), sigmoidf_(gv[1])); wg.y = pk_bf16(sigmoidf_(gv[2]), sigmoidf_(gv[3])); *(u32x2*)(gb + off) = wg;
                }
            }
        } else {
            if (wc == 0) {
#pragma unroll
                for (int ai = 0; ai < 2; ++ai)
#pragma unroll
                    for (int m = 0; m < 4; ++m) { float* rp = dd + (row0 + ai * 128 + m * 16) * 32 + 8 * fq;
                        *(f32x4*)rp = acc[ai][0][m][0]; *(f32x4*)(rp + 4) = acc[ai][0][m][1]; }
            }
        }
    }
};
template <int MODE> struct EpiGate {
    static constexpr bool PERM = true, DUAL = false; static constexpr int NT1 = 0; static constexpr long DA2 = 0, DB2 = 0;
    bf16_t* T; const bf16_t* sg;
    __device__ __forceinline__ void operator()(const f32x4 (&acc)[2][2][4][2], const Unit& un, int wr, int wc, int fr, int fq) const {
        const size_t row0 = (size_t)un.pm * 256 + wr * 64 + fr; const int col0 = un.pn * 256 + wc * 32 + 8 * fq;
#pragma unroll
        for (int ai = 0; ai < 2; ++ai)
#pragma unroll
            for (int m = 0; m < 4; ++m)
#pragma unroll
                for (int bj = 0; bj < 2; ++bj) { const size_t off = (row0 + ai * 128 + m * 16) * 1024 + col0 + bj * 128;
                    const u32x4 s = *(const u32x4*)(sg + off); const f32x4 a0 = acc[ai][bj][m][0], a1 = acc[ai][bj][m][1];
                    float o[8] = {a0[0] * bf_lo(s.x), a0[1] * bf_hi(s.x), a0[2] * bf_lo(s.y), a0[3] * bf_hi(s.y), a1[0] * bf_lo(s.z), a1[1] * bf_hi(s.z), a1[2] * bf_lo(s.w), a1[3] * bf_hi(s.w)};
                    if (MODE == 1) { const u32x4 t = *(const u32x4*)(T + off);
                        o[0] += bf_lo(t.x); o[1] += bf_hi(t.x); o[2] += bf_lo(t.y); o[3] += bf_hi(t.y); o[4] += bf_lo(t.z); o[5] += bf_hi(t.z); o[6] += bf_lo(t.w); o[7] += bf_hi(t.w); }
                    u32x4 w; w.x = pk_bf16(o[0], o[1]); w.y = pk_bf16(o[2], o[3]); w.z = pk_bf16(o[4], o[5]); w.w = pk_bf16(o[6], o[7]);
                    *(u32x4*)(T + off) = w; }
    }
};
struct EpiDual {
    static constexpr bool PERM = true, DUAL = true; static constexpr int NT1 = 16;
    static constexpr long DA2 = (long)OFF_G - (long)OFF_CB, DB2 = (long)OFF_WGLA - (long)OFF_WCONV;
    bf16_t* T; const bf16_t* sga; const bf16_t* sgb;
    __device__ __forceinline__ bool operator()(f32x4 (&acc)[2][2][4][2], const Unit& un, int wr, int wc, int fr, int fq) const {
        const unsigned lo = (unsigned)(fr * 2048 + fq * 16);
        const size_t ub = ((size_t)un.pm * 256 + wr * 64) * 2048 + ((size_t)un.pn * 256 + wc * 32) * 2;
        const char* pa = (const char*)sga + ub;
        if (un.kind == 0) {
            const char* pb = (const char*)sgb + ub;
#pragma unroll
            for (int ai = 0; ai < 2; ++ai)
#pragma unroll
                for (int mh = 0; mh < 2; ++mh) {
                    u32x4 a[2][2], b[2][2];
#pragma unroll
                    for (int mm = 0; mm < 2; ++mm)
#pragma unroll
                        for (int bj = 0; bj < 2; ++bj) { const int cb_ = (ai * 128 + (2 * mh + mm) * 16) * 2048 + bj * 256; a[mm][bj] = *(const u32x4*)(pa + cb_ + lo); b[mm][bj] = *(const u32x4*)(pb + cb_ + lo); }
#pragma unroll
                    for (int mm = 0; mm < 2; ++mm)
#pragma unroll
                        for (int bj = 0; bj < 2; ++bj) { const int m = 2 * mh + mm;
#pragma unroll
                            for (int e = 0; e < 4; ++e) { const float r0 = bf_lo(b[mm][bj][e]) * __builtin_amdgcn_rcpf(fmaxf(bf_lo(a[mm][bj][e]), 1e-30f)), r1 = bf_hi(b[mm][bj][e]) * __builtin_amdgcn_rcpf(fmaxf(bf_hi(a[mm][bj][e]), 1e-30f));
                                acc[ai][bj][m][e >> 1][2 * (e & 1)] *= r0; acc[ai][bj][m][e >> 1][2 * (e & 1) + 1] *= r1; } }
                    asm volatile("" ::: "memory");
                }
            return true;
        }
        char* pt = (char*)T + ub;
#pragma unroll
        for (int ai = 0; ai < 2; ++ai)
#pragma unroll
            for (int m = 0; m < 4; ++m)
#pragma unroll
                for (int bj = 0; bj < 2; ++bj) { const int cb_ = (ai * 128 + m * 16) * 2048 + bj * 256;
                    const u32x4 s = *(const u32x4*)(pa + cb_ + lo); const f32x4 a0 = acc[ai][bj][m][0], a1 = acc[ai][bj][m][1];
                    u32x4 w; w.x = pk_bf16(a0[0] * bf_lo(s.x), a0[1] * bf_hi(s.x)); w.y = pk_bf16(a0[2] * bf_lo(s.y), a0[3] * bf_hi(s.y));
                    w.z = pk_bf16(a1[0] * bf_lo(s.z), a1[1] * bf_hi(s.z)); w.w = pk_bf16(a1[2] * bf_lo(s.w), a1[3] * bf_hi(s.w));
                    *(u32x4*)(pt + cb_ + lo) = w; }
        return false;
    }
};
struct EpiRes {
    static constexpr bool PERM = true, DUAL = false; static constexpr int NT1 = 0; static constexpr long DA2 = 0, DB2 = 0;
    const float* xin; float* out; const float* gate;
    __device__ __forceinline__ void operator()(const f32x4 (&acc)[2][2][4][2], const Unit& un, int wr, int wc, int fr, int fq) const {
        const size_t row0 = (size_t)un.pm * 256 + wr * 64 + fr; const int col0 = un.pn * 256 + wc * 32 + 8 * fq;
        const float* gp = gate + (size_t)(un.pm >> 4) * 6144 + col0;
        f32x4 gv[2][2];
#pragma unroll
        for (int bj = 0; bj < 2; ++bj)
#pragma unroll
            for (int n = 0; n < 2; ++n) gv[bj][n] = *(const f32x4*)(gp + bj * 128 + 4 * n);
#pragma unroll
        for (int ai = 0; ai < 2; ++ai)
#pragma unroll
            for (int m = 0; m < 4; ++m)
#pragma unroll
                for (int bj = 0; bj < 2; ++bj)
#pragma unroll
                    for (int n = 0; n < 2; ++n) { const size_t off = (row0 + ai * 128 + m * 16) * 1024 + col0 + bj * 128 + 4 * n;
                        const f32x4 xv = *(const f32x4*)(xin + off); *(f32x4*)(out + off) = xv + gv[bj][n] * acc[ai][bj][m][n]; }
    }
};
struct EpiMix {
    static constexpr bool PERM = true, DUAL = false; static constexpr int NT1 = 0; static constexpr long DA2 = 0, DB2 = 0;
    const float* xin; float* out; const float* mod; const float* gffn; bf16_t* A2; float* rowss;
    __device__ __forceinline__ void operator()(const f32x4 (&acc)[2][2][4][2], const Unit& un, int wr, int wc, int fr, int fq) const {
        const size_t row0 = (size_t)un.pm * 256 + wr * 64 + fr; const int col0 = un.pn * 256 + wc * 32 + 8 * fq;
        const float* mp = mod + (size_t)(un.pm >> 4) * 6144 + col0;
        f32x4 gv[2][2], gam[2][2];
#pragma unroll
        for (int bj = 0; bj < 2; ++bj)
#pragma unroll
            for (int n = 0; n < 2; ++n) { gv[bj][n] = *(const f32x4*)(mp + 2048 + bj * 128 + 4 * n);
                gam[bj][n] = *(const f32x4*)(gffn + col0 + bj * 128 + 4 * n) * (*(const f32x4*)(mp + 4096 + bj * 128 + 4 * n) + 1.f); }
#pragma unroll
        for (int ai = 0; ai < 2; ++ai)
#pragma unroll
            for (int m = 0; m < 4; ++m) { const size_t rowb = (row0 + ai * 128 + m * 16) * 1024 + col0; float ss = 0.f;
#pragma unroll
                for (int bj = 0; bj < 2; ++bj) { f32x4 o[2];
#pragma unroll
                    for (int n = 0; n < 2; ++n) { const size_t off = rowb + bj * 128 + 4 * n; o[n] = *(const f32x4*)(xin + off) + gv[bj][n] * acc[ai][bj][m][n]; *(f32x4*)(out + off) = o[n];
#pragma unroll
                        for (int j = 0; j < 4; ++j) ss += o[n][j] * o[n][j]; }
                    const f32x4 a0 = o[0] * gam[bj][0], a1 = o[1] * gam[bj][1];
                    u32x4 w; w.x = pk_bf16(a0[0], a0[1]); w.y = pk_bf16(a0[2], a0[3]); w.z = pk_bf16(a1[0], a1[1]); w.w = pk_bf16(a1[2], a1[3]);
                    *(u32x4*)(A2 + rowb + bj * 128) = w; }
                ss += __shfl_xor(ss, 16); ss += __shfl_xor(ss, 32);
                if (fq == 0) (void)__hip_atomic_fetch_add(rowss + (row0 + ai * 128 + m * 16), ss, __ATOMIC_RELAXED, __HIP_MEMORY_SCOPE_AGENT); }
    }
};
struct EpiFfnIn {
    static constexpr bool PERM = true, DUAL = false; static constexpr int NT1 = 0; static constexpr long DA2 = 0, DB2 = 0;
    bf16_t* s; const float* rowss; const float* bias2;
    __device__ __forceinline__ void operator()(const f32x4 (&acc)[2][2][4][2], const Unit& un, int wr, int wc, int fr, int fq) const {
        const size_t row0 = (size_t)un.pm * 256 + wr * 64 + fr; const int col0 = un.pn * 128 + wc * 32 + 8 * fq;
        const float* bp = bias2 + (size_t)(un.pm >> 4) * (2 * DFF) + un.pn * 256 + wc * 32 + 8 * fq;
        f32x4 ba[2], bb[2]; float rs[2][4];
#pragma unroll
        for (int n = 0; n < 2; ++n) { ba[n] = *(const f32x4*)(bp + 4 * n); bb[n] = *(const f32x4*)(bp + 128 + 4 * n); }
#pragma unroll
        for (int ai = 0; ai < 2; ++ai)
#pragma unroll
            for (int m = 0; m < 4; ++m) rs[ai][m] = rsqrtf(rowss[row0 + ai * 128 + m * 16] * (1.f / 1024.f) + 1e-6f);
#pragma unroll
        for (int ai = 0; ai < 2; ++ai)
#pragma unroll
            for (int m = 0; m < 4; ++m) { float o[8];
#pragma unroll
                for (int n = 0; n < 2; ++n)
#pragma unroll
                    for (int j = 0; j < 4; ++j) { const float a = rs[ai][m] * acc[ai][0][m][n][j] + ba[n][j], b = rs[ai][m] * acc[ai][1][m][n][j] + bb[n][j]; o[4 * n + j] = a * sigmoidf_(a) * b; }
                u32x4 w; w.x = pk_bf16(o[0], o[1]); w.y = pk_bf16(o[2], o[3]); w.z = pk_bf16(o[4], o[5]); w.w = pk_bf16(o[6], o[7]);
                *(u32x4*)(s + (row0 + ai * 128 + m * 16) * DFF + col0) = w; }
    }
};

__device__ __forceinline__ void adaln_item(const Params& p, LAS unsigned char* lds, int it) {
    const int tid = threadIdx.x, lane = tid & 63, wid = tid >> 6;
    LAS float* sl = (LAS float*)lds;
    LAS float* red = sl + 9 * 1024;
    for (int i = tid; i < 9 * 1024; i += 512) { const int r = i >> 10, k = i & 1023; const float cv = r < 8 ? p.c[r * 1024 + k] : p.c_ctx[k]; sl[i] = cv / (1.f + __expf(-cv)); }
    __syncthreads();
    const int c0 = 32 * it, kg = tid >> 3, cq = tid & 7;
    float acc[9][4];
#pragma unroll
    for (int r = 0; r < 9; ++r)
#pragma unroll
        for (int j = 0; j < 4; ++j) acc[r][j] = 0.f;
    for (int kk = 0; kk < 16; ++kk) { const int k = kg * 16 + kk; const f32x4 w = *(const f32x4*)(p.w_ada + (size_t)k * 6144 + c0 + 4 * cq);
#pragma unroll
        for (int r = 0; r < 9; ++r) { const float s = sl[r * 1024 + k];
#pragma unroll
            for (int j = 0; j < 4; ++j) acc[r][j] += s * w[j]; } }
#pragma unroll
    for (int r = 0; r < 9; ++r)
#pragma unroll
        for (int j = 0; j < 4; ++j) { float v = acc[r][j]; v += __shfl_xor(v, 8); v += __shfl_xor(v, 16); v += __shfl_xor(v, 32); acc[r][j] = v; }
    if ((lane >> 3) == 0) {
#pragma unroll
        for (int r = 0; r < 9; ++r)
#pragma unroll
            for (int j = 0; j < 4; ++j) red[(wid * 9 + r) * 32 + 4 * cq + j] = acc[r][j]; }
    __syncthreads();
    if (tid < 288) { const int r = tid >> 5, cc = tid & 31; float s = 0.f;
#pragma unroll
        for (int w = 0; w < 8; ++w) s += red[(w * 9 + r) * 32 + cc];
        ((float*)(p.ws + OFF_MOD))[r * 6144 + c0 + cc] = s + p.b_ada[c0 + cc]; }
}
struct WTile { const float* src; bf16_t* dst; int sld, dld, n0, k0, srccol, nvalid, mode; };
__device__ __forceinline__ int win_src(int R) {
    const int pn = R >> 8, c = R & 255;
    if (pn < 12) return R;
    if (pn < 28) { const int T = pn - 12, bj = c >> 7, wc = (c >> 5) & 3, fq = (c >> 3) & 3, n = (c >> 2) & 1, j = c & 3, ch64 = 16 * wc + 4 * fq + j;
        const int base = bj == 0 ? (n == 0 ? 3104 : 4128) : (n == 0 ? 5152 : 7200); return base + 64 * T + ch64; }
    if (pn < 32) return 6176 + (R - 28 * 256);
    return c < 32 ? 3072 + c : -1;
}
__device__ __forceinline__ WTile wconv_decode(const Params& p, int j) {
    WTile t; int nt, kt; t.nvalid = 64; t.mode = 0;
    if (j < 2112) { nt = j >> 4; kt = j & 15; t.src = p.w_in; t.sld = NIN; t.dst = (bf16_t*)(p.ws + OFF_WIN); t.dld = 1024; t.srccol = 0; t.mode = 1;
    } else if (j < 2880) { const int jj = j - 2112, mi = jj >> 8, r = jj & 255; nt = r >> 4; kt = r & 15; t.sld = 1024; t.dld = 1024; t.srccol = nt * 64;
        t.src = mi == 0 ? p.w_gla_out : (mi == 1 ? p.w_conv_out : p.w_mix_out); t.dst = (bf16_t*)(p.ws + (mi == 0 ? OFF_WGLA : (mi == 1 ? OFF_WCONV : OFF_WMIX)));
    } else if (j < 4288) { const int jj = j - 2880; nt = jj >> 4; kt = jj & 15; t.src = p.w_ffn_in; t.sld = 2 * DFF; t.dst = (bf16_t*)(p.ws + OFF_WFFI); t.dld = 1024;
        const int n0 = nt * 64, pt = n0 >> 8, w = n0 & 255; t.srccol = w < 128 ? 128 * pt + w : DFF + 128 * pt + (w - 128);
    } else { const int jj = j - 4288; nt = jj / 44; kt = jj % 44; t.src = p.w_ffn_out; t.sld = 1024; t.dst = (bf16_t*)(p.ws + OFF_WFFO); t.dld = DFF; t.srccol = nt * 64; }
    t.n0 = nt * 64; t.k0 = kt * 64; return t;
}
__device__ __forceinline__ void wconv_load(const WTile& t, f32x4 (&r)[2]) {
    const int tid = threadIdx.x, n4 = (tid & 15) * 4;
    const int sc = t.mode ? win_src(t.n0 + n4) : (n4 < t.nvalid ? t.srccol + n4 : -1);
#pragma unroll
    for (int i = 0; i < 2; ++i) { const int kk = (tid >> 4) + 32 * i; r[i] = sc >= 0 ? *(const f32x4*)(t.src + (size_t)(t.k0 + kk) * t.sld + sc) : (f32x4){0.f, 0.f, 0.f, 0.f}; }
}
__device__ void wconv_run(const Params& p, LAS unsigned char* lds, int jbeg, int jend) {
    const int tid = threadIdx.x;
    LAS float* tile = (LAS float*)lds;
    int j = jbeg + (int)blockIdx.x; if (j >= jend) return;
    WTile cur = wconv_decode(p, j); f32x4 r[2]; wconv_load(cur, r);
    for (;;) {
        const int jn = j + (int)gridDim.x; const bool more = jn < jend;
        { const int n4 = (tid & 15) * 4;
#pragma unroll
            for (int i = 0; i < 2; ++i) { const int kk = (tid >> 4) + 32 * i;
#pragma unroll
                for (int e = 0; e < 4; ++e) tile[kk * 65 + n4 + e] = r[i][e]; } }
        WTile nxt = cur; if (more) { nxt = wconv_decode(p, jn); wconv_load(nxt, r); }
        __syncthreads();
        { const int jr = tid >> 3, kg = tid & 7; float v[8];
#pragma unroll
            for (int e = 0; e < 8; ++e) v[e] = tile[(8 * kg + e) * 65 + jr];
            u32x4 w; w.x = pk_bf16(v[0], v[1]); w.y = pk_bf16(v[2], v[3]); w.z = pk_bf16(v[4], v[5]); w.w = pk_bf16(v[6], v[7]);
            *(u32x4*)(cur.dst + (size_t)(cur.n0 + jr) * cur.dld + cur.k0 + 8 * kg) = w; }
        __syncthreads();
        if (!more) break;
        cur = nxt; j = jn;
    }
}
constexpr int WT_MIX_END = 2112 + 768, WT_END = 2112 + 768 + 1408 + 704;
__device__ void phase_prep(const Params& p, LAS unsigned char* lds) {
    if (blockIdx.x < 192) { adaln_item(p, lds, blockIdx.x); __syncthreads(); }
    wconv_run(p, lds, 0, WT_MIX_END);
}

__device__ __forceinline__ void norm_mod_rows(const float* src0, const float* src1, int nrows0, int nrows, bf16_t* dst, const float* gw, const float* mod, int sh_off, int sc_off) {
    const int lane = threadIdx.x & 63, wid = threadIdx.x >> 6, RS = (int)gridDim.x * 8;
    for (int rowa = blockIdx.x * 8 + wid; rowa < nrows; rowa += 2 * RS) {
        const bool has2 = rowa + RS < nrows;
        int rows[2] = {rowa, has2 ? rowa + RS : rowa};
        f32x4 v[2][4];
#pragma unroll
        for (int u = 0; u < 2; ++u) { const int row = rows[u]; const float* s = row < nrows0 ? src0 + (size_t)row * 1024 : src1 + (size_t)(row - nrows0) * 1024;
            v[u][0] = *(const f32x4*)(s + 8 * lane); v[u][1] = *(const f32x4*)(s + 8 * lane + 4); v[u][2] = *(const f32x4*)(s + 512 + 8 * lane); v[u][3] = *(const f32x4*)(s + 512 + 8 * lane + 4); }
#pragma unroll
        for (int u = 0; u < 2; ++u) {
            if (u == 1 && !has2) break;
            const int row = rows[u]; const int mr = row < nrows0 ? row / SEQ : 8;
            float ss = 0.f;
#pragma unroll
            for (int i = 0; i < 4; ++i)
#pragma unroll
                for (int j = 0; j < 4; ++j) ss += v[u][i][j] * v[u][i][j];
            ss = wave_sum(ss);
            const float rs = rsqrtf(ss * (1.f / 1024.f) + 1e-6f);
            const float* mp = mod + (size_t)mr * 6144;
#pragma unroll
            for (int hh = 0; hh < 2; ++hh) { const int c = hh * 512 + 8 * lane; float o[8];
#pragma unroll
                for (int q = 0; q < 2; ++q) { const f32x4 gg = *(const f32x4*)(gw + c + 4 * q), sc = *(const f32x4*)(mp + sc_off + c + 4 * q), sh = *(const f32x4*)(mp + sh_off + c + 4 * q);
#pragma unroll
                    for (int j = 0; j < 4; ++j) o[4 * q + j] = (v[u][2 * hh + q][j] * rs * gg[j]) * (1.f + sc[j]) + sh[j]; }
                u32x4 w; w.x = pk_bf16(o[0], o[1]); w.y = pk_bf16(o[2], o[3]); w.z = pk_bf16(o[4], o[5]); w.w = pk_bf16(o[6], o[7]);
                *(u32x4*)(dst + (size_t)row * 1024 + c) = w; }
        }
    }
}
__device__ void phase_final(const Params& p) {
    const int lane = threadIdx.x & 63, wid = threadIdx.x >> 6, RS = (int)gridDim.x * 8;
    for (int rowa = blockIdx.x * 8 + wid; rowa < ML; rowa += 2 * RS) {
        const bool has2 = rowa + RS < ML;
        int rows[2] = {rowa, has2 ? rowa + RS : rowa};
        f32x4 v[2][4];
#pragma unroll
        for (int u = 0; u < 2; ++u) { const float* s = p.out + (size_t)rows[u] * 1024;
            v[u][0] = *(const f32x4*)(s + 8 * lane); v[u][1] = *(const f32x4*)(s + 8 * lane + 4); v[u][2] = *(const f32x4*)(s + 512 + 8 * lane); v[u][3] = *(const f32x4*)(s + 512 + 8 * lane + 4); }
#pragma unroll
        for (int u = 0; u < 2; ++u) {
            if (u == 1 && !has2) break;
            float* s = p.out + (size_t)rows[u] * 1024;
            float ss = 0.f;
#pragma unroll
            for (int i = 0; i < 4; ++i)
#pragma unroll
                for (int j = 0; j < 4; ++j) ss += v[u][i][j] * v[u][i][j];
            ss = wave_sum(ss);
            const float rs = rsqrtf(ss * (1.f / 1024.f) + 1e-6f);
#pragma unroll
            for (int i = 0; i < 4; ++i) { const int c = (i >> 1) * 512 + 8 * lane + 4 * (i & 1); const f32x4 gg = *(const f32x4*)(p.g_final + c); *(f32x4*)(s + c) = v[u][i] * rs * gg; }
        }
    }
}

constexpr int A_DD = 0, A_QR = 8192, A_KR = 25600, A_HT = 43008, A_QD = 45056, A_KD = 79872, A_P = 114688, A_VT = 8192;
constexpr int A_RS = 272;
constexpr int A_PS = 144;
constexpr float QSCALE = 0.08838834764831845f;

template <int DIR, bool LAT>
__device__ __forceinline__ void gla_pass2(LAS unsigned char* lds, const float (&la)[32], int ch, int half, float bmid, float start, bf16_t* kdg  ) {
    float kv[32], qv[32];
#pragma unroll
    for (int i = 0; i < 32; ++i) { const int t = half * 32 + i;
        kv[i] = bf2f(*(const LAS bf16_t*)(lds + A_KR + t * A_RS + ch * 2));
        qv[i] = LAT ? bf2f(*(const LAS bf16_t*)(lds + A_QR + t * A_RS + ch * 2)) * QSCALE : 0.f; }
    float b = start; unsigned kp[16];
#pragma unroll
    for (int s = 0; s < 32; ++s) {
        const int i = DIR == 0 ? s : 31 - s; const int t = half * 32 + i;
        b += la[i];
        const float e1 = __expf(b - bmid), e2 = __builtin_amdgcn_rcpf(e1);
        const float kd = kv[i] * e2;
        const unsigned kb = pk_bf16(kd, 0.f) & 0xffffu;
        if ((i & 1) == 0) kp[i >> 1] = (DIR == 0) ? kb : (kp[i >> 1] | kb); else kp[i >> 1] = (DIR == 0) ? (kp[i >> 1] | (kb << 16)) : (kb << 16);
        if (LAT) {
            *(LAS bf16_t*)(lds + A_QD + DIR * 17408 + t * A_RS + ch * 2) = f2bf(qv[i] * e1);
            *(LAS bf16_t*)(lds + A_KD + DIR * 17408 + t * A_RS + ch * 2) = (bf16_t)kb;
        }
    }
    const int kt = ch >> 4, fr = ch & 15;
#pragma unroll
    for (int g4 = 0; g4 < 4; ++g4) { u32x4 w; w.x = kp[4 * g4]; w.y = kp[4 * g4 + 1]; w.z = kp[4 * g4 + 2]; w.w = kp[4 * g4 + 3];
        *(u32x4*)(kdg + ((kt * 2 + half) * 64 + g4 * 16 + fr) * 8) = w; }
}

__device__ void phase_gla_a(const Params& p, LAS unsigned char* lds, int vbid) {
    const int tid = threadIdx.x, lane = tid & 63, wid = tid >> 6, fr = lane & 15, fq = lane >> 4;
    const float* dd = (const float*)(p.ws + OFF_DD);
    const bf16_t* qb = (const bf16_t*)(p.ws + OFF_Q); const bf16_t* kb = (const bf16_t*)(p.ws + OFF_K);
    bf16_t* vb = (bf16_t*)(p.ws + OFF_V);
    bf16_t* Q2 = (bf16_t*)(p.ws + OFF_U); bf16_t* K2L = (bf16_t*)p.out; bf16_t* VTL = (bf16_t*)p.out + (size_t)32 * 1024 * 1024;
    bf16_t* K2C = (bf16_t*)(p.ws + OFF_WFFI); bf16_t* VTC = (bf16_t*)(p.ws + OFF_WFFI) + (size_t)2 * 1024 * 1024; float* dec = (float*)(p.ws + OFF_DEC);
#define GA_DECODE(it_, lat_, b_, c_, h_, row0_, cidx_) do { lat_ = (it_) < 2048; \
        if (lat_) { b_ = (it_) >> 8; c_ = ((it_) & 255) >> 2; h_ = (it_) & 3; row0_ = (size_t)b_ * SEQ + c_ * 64; cidx_ = c_; } \
        else { const int j_ = (it_) - 2048; b_ = j_ >> 4; c_ = (j_ & 15) >> 2; h_ = j_ & 3; row0_ = (size_t)ML + b_ * CTXL + c_ * 64; cidx_ = 64 + c_; } } while (0)
#define GA_FETCH_A(it_) do { if ((it_) < 2048 + 128) { bool l_; int b_, c_, h_, ci_; size_t r0_; GA_DECODE(it_, l_, b_, c_, h_, r0_, ci_); (void)ci_; \
        pdd = *(const f32x4*)(dd + (r0_ + (tid >> 3)) * 32 + 4 * (tid & 7)); \
        _Pragma("unroll") for (int i = 0; i < 2; ++i) { const int pc = tid + 512 * i, r = pc >> 4, cp = pc & 15; \
            pk[i] = *(const u32x4*)(kb + (r0_ + r) * 512 + h_ * 128 + 8 * cp); if (l_) pq[i] = *(const u32x4*)(qb + (r0_ + r) * 512 + h_ * 128 + 8 * cp); } } } while (0)
#define GA_FETCH_V(it_) do { if ((it_) < 2048 + 128) { bool l_; int b_, c_, h_, ci_; size_t r0_; GA_DECODE(it_, l_, b_, c_, h_, r0_, ci_); (void)ci_; (void)l_; \
        _Pragma("unroll") for (int i = 0; i < 4; ++i) pv[i] = *(const u32x4*)(vb + (r0_ + lane) * 1024 + h_ * 256 + 8 * (wid + 8 * i)); } } while (0)
    f32x4 pdd = {0.f, 0.f, 0.f, 0.f}; u32x4 pk[2], pq[2], pv[4];
    pk[0] = pk[1] = pq[0] = pq[1] = pv[0] = pv[1] = pv[2] = pv[3] = (u32x4){0u, 0u, 0u, 0u};
    const int ch = tid & 127, dir = (tid >> 7) & 1, half = tid >> 8;
    float w[16], bias = 0.f; int hw = -1;
#pragma unroll
    for (int r = 0; r < 16; ++r) w[r] = 0.f;
    GA_FETCH_A(vbid); GA_FETCH_V(vbid);
    for (int it = vbid; it < 2048 + 128; it += gridDim.x) {
        bool lat; int b, c, h; size_t row0; int cidx;
        GA_DECODE(it, lat, b, c, h, row0, cidx);
        { const int r = tid >> 3, c4 = tid & 7; *(LAS f32x4*)(lds + A_DD + r * 128 + c4 * 16) = pdd; }
#pragma unroll
        for (int i = 0; i < 2; ++i) { const int pc = tid + 512 * i, r = pc >> 4, cp = pc & 15;
            *(LAS u32x4*)(lds + A_KR + r * A_RS + cp * 16) = pk[i];
            if (lat) *(LAS u32x4*)(lds + A_QR + r * A_RS + cp * 16) = pq[i]; }
        if (h != hw) {
#pragma unroll
            for (int r = 0; r < 16; ++r) w[r] = p.w_dec_up[(size_t)(dir * 16 + r) * 512 + h * 128 + ch];
            bias = p.b_dec[dir * 512 + h * 128 + ch]; hw = h; }
        GA_FETCH_A(it + (int)gridDim.x);
        __syncthreads();
        float la[32]; float tot = 0.f;
#pragma unroll
        for (int g = 0; g < 8; ++g) {
            f32x4 d[4][4];
#pragma unroll
            for (int tt = 0; tt < 4; ++tt) { const LAS f32x4* dp = (const LAS f32x4*)(lds + A_DD + (half * 32 + 4 * g + tt) * 128 + dir * 64);
#pragma unroll
                for (int q4 = 0; q4 < 4; ++q4) d[tt][q4] = dp[q4]; }
            asm volatile("" ::: "memory");
#pragma unroll
            for (int tt = 0; tt < 4; ++tt) { float z0 = bias, z1 = 0.f;
#pragma unroll
                for (int q4 = 0; q4 < 4; ++q4) { z0 += d[tt][q4][0] * w[4 * q4]; z1 += d[tt][q4][1] * w[4 * q4 + 1]; z0 += d[tt][q4][2] * w[4 * q4 + 2]; z1 += d[tt][q4][3] * w[4 * q4 + 3]; }
                const float z = z0 + z1;
                const float l = (fminf(z, 0.f) - 0.69314718056f * __builtin_amdgcn_logf(1.f + __expf(-fabsf(z)))) * (1.f / 16.f);
                la[4 * g + tt] = l; tot += l; } }
        ((LAS float*)(lds + A_HT))[(dir * 2 + half) * 128 + ch] = tot;
        __syncthreads();
        { const float h0 = ((LAS float*)(lds + A_HT))[(dir * 2 + 0) * 128 + ch], h1 = ((LAS float*)(lds + A_HT))[(dir * 2 + 1) * 128 + ch];
            const float blast = h0 + h1, bmid = dir == 0 ? h0 : h1;
            const size_t cbase = (((size_t)dir * 8 + b) * 4 + h) * NCH + cidx;
            const size_t gb_ = ((size_t)dir * 8 + b) * 4 + h;
            bf16_t* kdg = lat ? K2L + (gb_ * 64 + c) * 8192 : K2C + (gb_ * 4 + c) * 8192;
            if (dir == 0) { if (lat) gla_pass2<0, true>(lds, la, ch, half, bmid, half ? h0 : 0.f, kdg); else gla_pass2<0, false>(lds, la, ch, half, bmid, half ? h0 : 0.f, kdg); }
            else { if (lat) gla_pass2<1, true>(lds, la, ch, half, bmid, half ? 0.f : h1, kdg); else gla_pass2<1, false>(lds, la, ch, half, bmid, half ? 0.f : h1, kdg); }
            if (half == 0) { float* sp = dec + cbase * 384 + ch; sp[0] = __expf(blast); sp[128] = __expf(blast - bmid); ((LAS float*)(lds + A_DD))[dir * 128 + ch] = __expf(bmid); } }
        __syncthreads();
#pragma unroll
        for (int i = 0; i < 4; ++i) { const int t = lane, cp = wid + 8 * i;
            const u32x4 vv = pv[i];
#pragma unroll
            for (int e = 0; e < 4; ++e) { *(LAS bf16_t*)(lds + A_VT + (8 * cp + 2 * e) * A_PS + t * 2) = (bf16_t)(vv[e] & 0xffffu); *(LAS bf16_t*)(lds + A_VT + (8 * cp + 2 * e + 1) * A_PS + t * 2) = (bf16_t)(vv[e] >> 16); } }
        GA_FETCH_V(it + (int)gridDim.x);
        if (lat) {
            const int rt = wid >> 1, ct0 = (wid & 1) * 2;
            f32x4 ps[2] = {{0.f, 0.f, 0.f, 0.f}, {0.f, 0.f, 0.f, 0.f}};
#pragma unroll
            for (int d = 0; d < 2; ++d)
#pragma unroll
                for (int cc = 0; cc < 2; ++cc) { const int ct = ct0 + cc; f32x4 a = {0.f, 0.f, 0.f, 0.f};
#pragma unroll
                    for (int ks = 0; ks < 4; ++ks) { const bf16x8 af = *(const LAS bf16x8*)(lds + A_QD + d * 17408 + (16 * rt + fr) * A_RS + (32 * ks + 8 * fq) * 2), bfr = *(const LAS bf16x8*)(lds + A_KD + d * 17408 + (16 * ct + fr) * A_RS + (32 * ks + 8 * fq) * 2);
                        a = __builtin_amdgcn_mfma_f32_16x16x32_bf16(af, bfr, a, 0, 0, 0); }
#pragma unroll
                    for (int r = 0; r < 4; ++r) { const int i = 16 * rt + 4 * fq + r, j = 16 * ct + fr; const bool keep = d == 0 ? (i >= j) : (j >= i); ps[cc][r] += keep ? a[r] : 0.f; } }
#pragma unroll
            for (int cc = 0; cc < 2; ++cc)
#pragma unroll
                for (int r = 0; r < 4; ++r) *(LAS bf16_t*)(lds + A_P + (16 * rt + 4 * fq + r) * A_PS + (16 * (ct0 + cc) + fr) * 2) = f2bf(ps[cc][r]);
        }
        __syncthreads();
        { bf16_t* vtg = lat ? VTL + (((size_t)b * 4 + h) * 64 + c) * 16384 : VTC + (((size_t)b * 4 + h) * 4 + c) * 16384;
#pragma unroll
            for (int i = 0; i < 4; ++i) { const int pc = tid + 512 * i, vc = pc >> 3, tp = pc & 7;
                *(u32x4*)(vtg + (((vc >> 4) * 2 + (tp >> 2)) * 64 + (tp & 3) * 16 + (vc & 15)) * 8) = *(const LAS u32x4*)(lds + A_VT + vc * A_PS + tp * 16); } }
        if (lat) {
#pragma unroll
            for (int d = 0; d < 2; ++d) { bf16_t* qg = Q2 + ((((size_t)d * 8 + b) * 4 + h) * 64 + c) * 8192;
#pragma unroll
                for (int i = 0; i < 2; ++i) { const int pc = tid + 512 * i, t = pc >> 4, cp = pc & 15;
                    const u32x4 qv = *(const LAS u32x4*)(lds + A_QD + d * 17408 + t * A_RS + cp * 16);
                    const f32x4 e0 = *(const LAS f32x4*)(lds + A_DD + (d * 128 + 8 * cp) * 4), e1 = *(const LAS f32x4*)(lds + A_DD + (d * 128 + 8 * cp + 4) * 4);
                    u32x4 w; w.x = pk_bf16(bf_lo(qv.x) * e0[0], bf_hi(qv.x) * e0[1]); w.y = pk_bf16(bf_lo(qv.y) * e0[2], bf_hi(qv.y) * e0[3]);
                    w.z = pk_bf16(bf_lo(qv.z) * e1[0], bf_hi(qv.z) * e1[1]); w.w = pk_bf16(bf_lo(qv.w) * e1[2], bf_hi(qv.w) * e1[3]);
                    *(u32x4*)(qg + (((t >> 4) * 4 + (cp >> 2)) * 64 + (cp & 3) * 16 + (t & 15)) * 8) = w; } }
        }
        if (lat) {
#pragma unroll
            for (int vv = 0; vv < 2; ++vv) { const int vct = 2 * wid + vv;
#pragma unroll
                for (int rt = 0; rt < 4; ++rt) { f32x4 a = {0.f, 0.f, 0.f, 0.f};
#pragma unroll
                    for (int ks = 0; ks < 2; ++ks) { const bf16x8 af = *(const LAS bf16x8*)(lds + A_VT + (16 * vct + fr) * A_PS + (32 * ks + 8 * fq) * 2), bfr = *(const LAS bf16x8*)(lds + A_P + (16 * rt + fr) * A_PS + (32 * ks + 8 * fq) * 2);
                        a = __builtin_amdgcn_mfma_f32_16x16x32_bf16(af, bfr, a, 0, 0, 0); }
                    u32x2 w; w.x = pk_bf16(a[0], a[1]); w.y = pk_bf16(a[2], a[3]);
                    *(u32x2*)(vb + (row0 + 16 * rt + fr) * 1024 + h * 256 + 16 * vct + 4 * fq) = w; } }
        }
        __syncthreads();
    }
}

constexpr int B_SLOT = 41984;
constexpr int B_ST = 2 * B_SLOT, B_STS = 272;
__device__ void phase_gla_b(const Params& p, LAS unsigned char* lds, int vbid) {
    const int tid = threadIdx.x, lane = tid & 63, wid = __builtin_amdgcn_readfirstlane(tid >> 6), fr = lane & 15, fq = lane >> 4;
    const bf16_t* QD = (const bf16_t*)(p.ws + OFF_U); const bf16_t* K2L = (const bf16_t*)p.out; const bf16_t* VTL = (const bf16_t*)p.out + (size_t)32 * 1024 * 1024;
    const bf16_t* K2C = (const bf16_t*)(p.ws + OFF_WFFI); const bf16_t* VTC = (const bf16_t*)(p.ws + OFF_WFFI) + (size_t)2 * 1024 * 1024; const float* scal = (const float*)(p.ws + OFF_DEC);
    bf16_t* of = (bf16_t*)(p.ws + OFF_Q); bf16_t* vb = (bf16_t*)(p.ws + OFF_V);
    const int kt0 = (wid >> 1) * 2, ct0 = (wid & 1) * 2, rt = wid & 3, vct0 = (wid >> 2) * 2;
    for (int it = vbid; it < 256; it += gridDim.x) {
        const int grp = (it & 7) * 8 + ((it >> 3) >> 2), vs = (it >> 3) & 3, b = grp >> 3, h = (grp >> 1) & 3, dir = grp & 1;
        const size_t gbase = (((size_t)dir * 8 + b) * 4 + h);
        const bf16_t* k2l = K2L + gbase * 64 * 8192 + wid * 512 + lane * 8; const bf16_t* k2c = K2C + gbase * 4 * 8192 + wid * 512 + lane * 8;
        const bf16_t* vtl = VTL + (((size_t)b * 4 + h) * 64) * 16384 + (size_t)(vs * 8 + wid) * 512 + lane * 8; const bf16_t* vtc = VTC + (((size_t)b * 4 + h) * 4) * 16384 + (size_t)(vs * 8 + wid) * 512 + lane * 8;
        const bf16_t* q2b = QD + gbase * 64 * 8192 + wid * 512 + lane * 8;
        const float* dcb = scal + gbase * NCH * 384 + lane * 4;
        f32x4 S[2][2];
#pragma unroll
        for (int i = 0; i < 2; ++i)
#pragma unroll
            for (int j = 0; j < 2; ++j) S[i][j] = (f32x4){0.f, 0.f, 0.f, 0.f};
        u32x4 RA[6], RB[6]; u32x2 obA[2], obB[2];
        obA[0] = obA[1] = obB[0] = obB[1] = (u32x2){0u, 0u};
#define GB_STAGE(R, n_) do { const int nn_ = (n_) < NCH ? (n_) : NCH - 1; const int ci_ = dir == 0 ? (nn_ < 4 ? 64 + nn_ : nn_ - 4) : 67 - nn_; const int cq_ = nn_ < 4 ? 0 : (dir == 0 ? nn_ - 4 : 67 - nn_); \
            const bf16_t* kp_ = ci_ < 64 ? k2l + (size_t)ci_ * 8192 : k2c + (size_t)(ci_ - 64) * 8192; const bf16_t* vp_ = ci_ < 64 ? vtl + (size_t)ci_ * 16384 : vtc + (size_t)(ci_ - 64) * 16384; \
            R[0] = *(const u32x4*)(kp_); R[1] = *(const u32x4*)(kp_ + 8 * 512); R[2] = *(const u32x4*)(vp_); \
            R[3] = *(const u32x4*)(q2b + (size_t)cq_ * 8192); R[4] = *(const u32x4*)(q2b + (size_t)cq_ * 8192 + 8 * 512); \
            if (wid == 0) R[5] = *(const u32x4*)(dcb + (size_t)ci_ * 384); } while (0)
#define GB_OBLOAD(OB, n_) do { if (dir == 1 && (n_) >= 4 && (n_) < NCH) { const int ncl_ = 67 - (n_); \
            _Pragma("unroll") for (int jj = 0; jj < 2; ++jj) OB[jj] = *(const u32x2*)(vb + ((size_t)b * SEQ + ncl_ * 64 + 16 * rt + fr) * 1024 + h * 256 + vs * 64 + 16 * (vct0 + jj) + 4 * fq); } } while (0)
#define GB_STEP(R, OB, n) do { \
            const bool lat = (n) >= 4; const int cl = dir == 0 ? (n) - 4 : 67 - (n); \
            LAS unsigned char* slot = lds + ((n) & 1) * B_SLOT; \
            LAS unsigned char* st = lds + B_ST + ((n) & 1) * 17408; \
            *(LAS u32x4*)(slot + wid * 1024 + lane * 16) = R[0]; *(LAS u32x4*)(slot + (wid + 8) * 1024 + lane * 16) = R[1]; *(LAS u32x4*)(slot + 16384 + wid * 1024 + lane * 16) = R[2]; \
            *(LAS u32x4*)(slot + 24576 + wid * 1024 + lane * 16) = R[3]; *(LAS u32x4*)(slot + 24576 + (wid + 8) * 1024 + lane * 16) = R[4]; \
            if (wid == 0) *(LAS u32x4*)(slot + 40960 + lane * 16) = R[5]; \
            if (lat) { \
                _Pragma("unroll") for (int i = 0; i < 2; ++i) \
                    _Pragma("unroll") for (int j = 0; j < 2; ++j) { const f32x4 sv = S[i][j]; u32x2 w; w.x = pk_bf16(sv[0], sv[1]); w.y = pk_bf16(sv[2], sv[3]); \
                        *(LAS u32x2*)(st + (16 * (ct0 + j) + fr) * B_STS + (16 * (kt0 + i) + 4 * fq) * 2) = w; } } \
            GB_STAGE(R, (n) + 2); \
            __syncthreads(); \
            _Pragma("unroll") for (int i = 0; i < 2; ++i) { \
                const f32x4 dcv = *(const LAS f32x4*)(slot + 40960 + (16 * (kt0 + i) + 4 * fq) * 4), elv = *(const LAS f32x4*)(slot + 40960 + 512 + (16 * (kt0 + i) + 4 * fq) * 4); \
                _Pragma("unroll") for (int j = 0; j < 2; ++j) { f32x4 pacc = {0.f, 0.f, 0.f, 0.f}; \
                    _Pragma("unroll") for (int ks = 0; ks < 2; ++ks) { const bf16x8 kfr = *(const LAS bf16x8*)(slot + ((kt0 + i) * 2 + ks) * 1024 + lane * 16), vfr = *(const LAS bf16x8*)(slot + 16384 + ((ct0 + j) * 2 + ks) * 1024 + lane * 16); \
                        pacc = __builtin_amdgcn_mfma_f32_16x16x32_bf16(kfr, vfr, pacc, 0, 0, 0); } \
                    S[i][j] = S[i][j] * dcv + pacc * elv; } } \
            if (lat) { \
                _Pragma("unroll") for (int jj = 0; jj < 2; ++jj) { f32x4 a = {0.f, 0.f, 0.f, 0.f}; \
                    _Pragma("unroll") for (int ks = 0; ks < 4; ++ks) { const bf16x8 af = *(const LAS bf16x8*)(st + (16 * (vct0 + jj) + fr) * B_STS + (32 * ks + 8 * fq) * 2), qfr = *(const LAS bf16x8*)(slot + 24576 + (rt * 4 + ks) * 1024 + lane * 16); \
                        a = __builtin_amdgcn_mfma_f32_16x16x32_bf16(af, qfr, a, 0, 0, 0); } \
                    const size_t off = ((size_t)b * SEQ + cl * 64 + 16 * rt + fr) * 1024 + h * 256 + vs * 64 + 16 * (vct0 + jj) + 4 * fq; \
                    if (dir == 0) { u32x2 w; w.x = pk_bf16(a[0], a[1]); w.y = pk_bf16(a[2], a[3]); *(u32x2*)(of + off) = w; } \
                    else { const u32x2 o = OB[jj]; u32x2 w; w.x = pk_bf16(a[0] + bf_lo(o.x), a[1] + bf_hi(o.x)); w.y = pk_bf16(a[2] + bf_lo(o.y), a[3] + bf_hi(o.y)); *(u32x2*)(vb + off) = w; } } \
            } \
            GB_OBLOAD(OB, (n) + 2); } while (0)
        RA[5] = RB[5] = (u32x4){0u, 0u, 0u, 0u};
        GB_STAGE(RA, 0); GB_STAGE(RB, 1); GB_OBLOAD(obA, 4); GB_OBLOAD(obB, 5);
#pragma unroll 1
        for (int n = 0; n < NCH; n += 2) { GB_STEP(RA, obA, n); GB_STEP(RB, obB, n + 1); }
        __syncthreads();
#undef GB_STEP
#undef GB_OBLOAD
#undef GB_STAGE
    }
}

__device__ void phase_agla(const Params& p) {
    const int lane = threadIdx.x & 63, wid = threadIdx.x >> 6, sub = lane >> 5, l32 = lane & 31;
    const bf16_t* o1 = (const bf16_t*)(p.ws + OFF_V); const bf16_t* o2 = (const bf16_t*)(p.ws + OFF_Q); bf16_t* g = (bf16_t*)(p.ws + OFF_G);
    const f32x4 gh0 = *(const f32x4*)(p.g_head + 8 * l32), gh1 = *(const f32x4*)(p.g_head + 8 * l32 + 4);
    for (int i0 = (blockIdx.x * 8 + wid) * 8; i0 < ML * 4; i0 += gridDim.x * 64) {
        u32x4 a[4], b[4], gs[4]; size_t off[4];
#pragma unroll
        for (int st = 0; st < 4; ++st) { const int idx = i0 + 2 * st + sub; off[st] = (size_t)(idx >> 2) * 1024 + (idx & 3) * 256 + 8 * l32;
            a[st] = *(const u32x4*)(o1 + off[st]); b[st] = *(const u32x4*)(o2 + off[st]); gs[st] = *(const u32x4*)(g + off[st]); }
#pragma unroll
        for (int st = 0; st < 4; ++st) {
            float o[8];
#pragma unroll
            for (int e = 0; e < 4; ++e) { o[2 * e] = bf_lo(a[st][e]) + bf_lo(b[st][e]); o[2 * e + 1] = bf_hi(a[st][e]) + bf_hi(b[st][e]); }
            float ss = 0.f;
#pragma unroll
            for (int e = 0; e < 8; ++e) ss += o[e] * o[e];
#pragma unroll
            for (int m = 16; m > 0; m >>= 1) ss += __shfl_xor(ss, m);
            const float rs = rsqrtf(ss * (1.f / 256.f) + 1e-6f);
            float r[8];
#pragma unroll
            for (int e = 0; e < 4; ++e) { r[2 * e] = o[2 * e] * rs * (e < 2 ? gh0[2 * e] : gh1[2 * e - 4]) * bf_lo(gs[st][e]); r[2 * e + 1] = o[2 * e + 1] * rs * (e < 2 ? gh0[2 * e + 1] : gh1[2 * e - 3]) * bf_hi(gs[st][e]); }
            u32x4 w; w.x = pk_bf16(r[0], r[1]); w.y = pk_bf16(r[2], r[3]); w.z = pk_bf16(r[4], r[5]); w.w = pk_bf16(r[6], r[7]);
            *(u32x4*)(g + off[st]) = w;
        }
    }
}

__device__ void ffn_bias(const Params& p) {
    const int lane = threadIdx.x & 63, wid = threadIdx.x >> 6;
    const bf16_t* W = (const bf16_t*)(p.ws + OFF_WFFI); const float* mod = (const float*)(p.ws + OFF_MOD); float* bias2 = (float*)(p.ws + OFF_BIAS2);
    for (int n = blockIdx.x * 8 + wid; n < 2 * DFF; n += gridDim.x * 8) {
        const u32x4 w0 = *(const u32x4*)(W + (size_t)n * 1024 + 8 * lane), w1 = *(const u32x4*)(W + (size_t)n * 1024 + 512 + 8 * lane);
        float wv[16];
#pragma unroll
        for (int e = 0; e < 4; ++e) { wv[2 * e] = bf_lo(w0[e]); wv[2 * e + 1] = bf_hi(w0[e]); wv[8 + 2 * e] = bf_lo(w1[e]); wv[8 + 2 * e + 1] = bf_hi(w1[e]); }
#pragma unroll
        for (int b = 0; b < 8; ++b) { const float* sp = mod + (size_t)b * 6144 + 3072; float a = 0.f;
#pragma unroll
            for (int q = 0; q < 2; ++q) { const f32x4 s0 = *(const f32x4*)(sp + 8 * lane + 4 * q), s1 = *(const f32x4*)(sp + 512 + 8 * lane + 4 * q);
#pragma unroll
                for (int j = 0; j < 4; ++j) a += s0[j] * wv[4 * q + j] + s1[j] * wv[8 + 4 * q + j]; }
            a = wave_sum(a);
            if (lane == 0) bias2[(size_t)b * (2 * DFF) + n] = a; }
    }
}
__device__ void zero_rowss(const Params& p) {
    float* r = (float*)(p.ws + OFF_ROWSS);
    for (int i = blockIdx.x * 512 + threadIdx.x; i < ML; i += gridDim.x * 512) r[i] = 0.f;
}

__device__ __forceinline__ void run_phase(const Params& p, LAS unsigned char* lds, int ph, int vbid) {
    unsigned char* ws = p.ws; const float* mod = (const float*)(ws + OFF_MOD);
    const int G = (int)gridDim.x, c = vbid;
    switch (ph) {
    case 0: phase_prep(p, lds); break;
    case 1: norm_mod_rows(p.x, p.ctx, ML, MT, (bf16_t*)p.out, p.g_mix, mod, 0, 1024); break;
    case 2: { pg8::Gemm g{(const bf16_t*)p.out, (const bf16_t*)(ws + OFF_WIN), MT, NINP, 1024, 16}; pg8::InOrder S; S.init(G, c);
        EpiInProj E{(bf16_t*)(ws + OFF_Q), (bf16_t*)(ws + OFF_K), (bf16_t*)(ws + OFF_V), (bf16_t*)(ws + OFF_G), (bf16_t*)(ws + OFF_CB), (bf16_t*)(ws + OFF_GA), (bf16_t*)(ws + OFF_GB), (float*)(ws + OFF_DD), p.w_conv};
        pg8::gemm_phase(lds, g, S, E); } break;
    case 5: phase_gla_a(p, lds, vbid); break;
    case 6: phase_gla_b(p, lds, vbid); break;
    case 7: wconv_run(p, lds, WT_MIX_END, WT_END); zero_rowss(p); phase_agla(p); break;
    case 8: { ffn_bias(p); pg8::Gemm g{(const bf16_t*)(ws + OFF_CB), (const bf16_t*)(ws + OFF_WCONV), ML, 1024, 1024, 16}; pg8::DualOrder S; S.init(ML, 1024, G, c);
        EpiDual E{(bf16_t*)(ws + OFF_U), (const bf16_t*)(ws + OFF_GA), (const bf16_t*)(ws + OFF_GB)}; pg8::gemm_phase(lds, g, S, E); } break;
    case 9: { pg8::Gemm g{(const bf16_t*)(ws + OFF_U), (const bf16_t*)(ws + OFF_WMIX), ML, 1024, 1024, 16}; pg8::StaticOrder S; S.init(ML, 1024, G, c);
        EpiMix E{p.x, p.out, mod, p.g_ffn, (bf16_t*)(ws + OFF_G), (float*)(ws + OFF_ROWSS)}; pg8::gemm_phase(lds, g, S, E); } break;
    case 11: { pg8::Gemm g{(const bf16_t*)(ws + OFF_G), (const bf16_t*)(ws + OFF_WFFI), ML, 2 * DFF, 1024, 16}; pg8::StaticOrder S; S.init(ML, 2 * DFF, G, c);
        EpiFfnIn E{(bf16_t*)(ws + OFF_GA), (const float*)(ws + OFF_ROWSS), (const float*)(ws + OFF_BIAS2)}; pg8::gemm_phase(lds, g, S, E); } break;
    case 12: { pg8::Gemm g{(const bf16_t*)(ws + OFF_GA), (const bf16_t*)(ws + OFF_WFFO), ML, 1024, DFF, DFF / 64}; pg8::StaticOrder S; S.init(ML, 1024, G, c);
        EpiRes E{p.out, p.out, mod + 5120}; pg8::gemm_phase(lds, g, S, E); } break;
    case 13: phase_final(p); break;
    default: break;
    }
}

#if FUSED
__global__ void __launch_bounds__(512, 2) mega_fwd(Params p) {
    extern __shared__ __attribute__((aligned(16))) unsigned char shm[];
    LAS unsigned char* lds = (LAS unsigned char*)shm;
    volatile LAS unsigned* xst = (volatile LAS unsigned*)(lds + LDS_STAGE);
    if (threadIdx.x == 0) { xst[0] = 0u; xst[1] = 0u; xst[2] = 0u; xst[3] = 0u; }
    __syncthreads();
    const XcdBarrier xb = xcd_barrier_post((unsigned*)(p.ws + OFF_BAR), xst);
    if (threadIdx.x == 0) xst[2] = xb_add(&xb.bar[xb.x], 1u);
    int vbid = (int)blockIdx.x;
#define VBID_SETUP() do { if (threadIdx.x == 0) { unsigned cnt[16], tot = 0u, nx = 0u, pre = 0u, kx = 0u; bool eq = true; \
        _Pragma("unroll") for (unsigned j = 0; j < 16; ++j) { cnt[j] = xb_ld(&xb.bar[XB_XCNT(j)]); } \
        _Pragma("unroll") for (unsigned j = 0; j < 16; ++j) { if (cnt[j]) { if (j < xb.x) { pre += cnt[j]; ++kx; } ++nx; tot += cnt[j]; eq = eq && (cnt[j] == cnt[xb.x]); } } \
        const unsigned rank = xst[2]; xst[3] = (eq && tot == gridDim.x && nx == 8u) ? rank * 8u + kx : pre + rank; } \
        __syncthreads(); vbid = (int)xst[3]; if (vbid < 0 || vbid >= (int)gridDim.x) vbid = (int)blockIdx.x; } while (0)
#define GSYNC(n) do { xcd_barrier(xb); if ((n) == 0) VBID_SETUP(); } while (0)
#ifdef TPROBE
    unsigned long long tsum_sync = 0, tsum_sel = 0, t0, t1;
#define PH(n) t0 = __builtin_amdgcn_s_memrealtime(); run_phase(p, lds, n, vbid); asm volatile("" ::: "memory"); t1 = __builtin_amdgcn_s_memrealtime(); if ((TPROBE_MASK >> (n)) & 1) tsum_sel += t1 - t0; \
    GSYNC(n); asm volatile("" ::: "memory"); t0 = __builtin_amdgcn_s_memrealtime(); tsum_sync += t0 - t1;
    PH(0) PH(1) PH(2) PH(5) PH(6) PH(7) PH(8) PH(9) PH(11) PH(12)
    t0 = __builtin_amdgcn_s_memrealtime(); run_phase(p, lds, 13, vbid); t1 = __builtin_amdgcn_s_memrealtime(); if ((TPROBE_MASK >> 13) & 1) tsum_sel += t1 - t0;
    if (blockIdx.x == 0) { const unsigned long long want = 2ull * (TPROBE_SYNC ? tsum_sync : tsum_sel); const unsigned long long ts = __builtin_amdgcn_s_memrealtime();
        while (__builtin_amdgcn_s_memrealtime() - ts < want) __builtin_amdgcn_s_sleep(8); }
#undef PH
#else
#define PH(n) run_phase(p, lds, n, vbid); asm volatile("" ::: "memory"); GSYNC(n); asm volatile("" ::: "memory");
    PH(0) PH(1) PH(2) PH(5) PH(6) PH(7) PH(8) PH(9) PH(11) PH(12)
    run_phase(p, lds, 13, vbid);
#undef PH
#endif
}
#else
__global__ void __launch_bounds__(512, 2) mega_fwd(Params p, int ph) {
    extern __shared__ __attribute__((aligned(16))) unsigned char shm[];
    LAS unsigned char* lds = (LAS unsigned char*)shm;
    run_phase(p, lds, ph, (int)blockIdx.x);
}
#endif

extern "C" void kernel_launch(void* const* d_in, const int* in_sizes, int n_in, void* d_out, int out_size, void* d_ws, size_t ws_size, hipStream_t stream) {
    static int grid = 0;
    if (grid == 0) {
        if (n_in != 19 || out_size != ML * DM || ws_size < WS_NEED) { fprintf(stderr, "kernel_launch: unexpected shapes (n_in %d out %d ws %zu need %zu)\n", n_in, out_size, ws_size, (size_t)WS_NEED); grid = -1; return; }
        int dev = 0, cus = 0, per_cu = 0;
        (void)hipGetDevice(&dev); (void)hipDeviceGetAttribute(&cus, hipDeviceAttributeMultiprocessorCount, dev);
        if (hipFuncSetAttribute((const void*)mega_fwd, hipFuncAttributeMaxDynamicSharedMemorySize, LDS_BYTES) != hipSuccess) { fprintf(stderr, "hipFuncSetAttribute failed\n"); grid = -1; return; }
        if (hipOccupancyMaxActiveBlocksPerMultiprocessor(&per_cu, (const void*)mega_fwd, 512, LDS_BYTES) != hipSuccess || per_cu < 1) { fprintf(stderr, "occupancy query failed (%d)\n", per_cu); (void)hipGetLastError(); per_cu = 1; }
        if (per_cu > 1) per_cu = 1;
        grid = cus * per_cu;
    }
    if (grid < 0) return;
    Params p{};
    const float** f = (const float**)&p;
    for (int i = 0; i < 19; ++i) f[i] = (const float*)d_in[i];
    p.out = (float*)d_out; p.ws = (unsigned char*)d_ws;
#if FUSED
    (void)hipMemsetAsync((char*)d_ws + OFF_BAR, 0, BAR_BYTES, stream);
    void* args[] = {&p};
    hipError_t e = hipLaunchCooperativeKernel((const void*)mega_fwd, dim3(grid), dim3(512), args, LDS_BYTES, stream);
    if (e != hipSuccess) fprintf(stderr, "cooperative launch failed: %s (grid %d)\n", hipGetErrorString(e), grid);
#else
    for (int ph = 0; ph < NPHASE; ++ph) hipLaunchKernelGGL(mega_fwd, dim3(grid), dim3(512), LDS_BYTES, stream, p, ph);
#endif
}
```

```cpp
#include <hip/hip_runtime.h>
#include <hip/hip_cooperative_groups.h>
#include <cstdio>
namespace cg = cooperative_groups;

#ifndef FUSED
#define FUSED 1
#endif

#define LAS __attribute__((address_space(3)))
typedef unsigned short bf16_t;
typedef short bf16x8 __attribute__((ext_vector_type(8)));
typedef float f32x4 __attribute__((ext_vector_type(4)));
typedef unsigned u32x4 __attribute__((ext_vector_type(4)));
typedef unsigned u32x2 __attribute__((ext_vector_type(2)));

constexpr int DM = 1024, NB = 8, SEQ = 4096, CTXL = 256;
constexpr int ML = NB * SEQ, MC = NB * CTXL, MT = ML + MC;
constexpr int DFF = 2816, NIN = 8224, NINP = 8448, NCH = 68;
constexpr int LDS_STAGE = 131072;
constexpr int LDS_BYTES = LDS_STAGE + 16;
constexpr int NPHASE = 14;

constexpr size_t OFF_WIN = 0;
constexpr size_t OFF_WGLA = OFF_WIN + (size_t)NINP * 1024 * 2;
constexpr size_t OFF_WCONV = OFF_WGLA + 2097152;
constexpr size_t OFF_WMIX = OFF_WCONV + 2097152;
constexpr size_t OFF_WFFI = OFF_WMIX + 2097152;
constexpr size_t OFF_WFFO = OFF_WFFI + (size_t)5632 * 1024 * 2;
constexpr size_t OFF_MOD = OFF_WFFO + (size_t)1024 * 2816 * 2;
constexpr size_t OFF_DEC = OFF_MOD + (size_t)9 * 6144 * 4;
constexpr size_t OFF_DD = OFF_DEC + (size_t)2 * 8 * 4 * NCH * 384 * 4;
constexpr size_t OFF_Q = OFF_DD + (size_t)MT * 32 * 4;
constexpr size_t OFF_K = OFF_Q + (size_t)ML * 512 * 2;
constexpr size_t OFF_V = OFF_K + (size_t)MT * 512 * 2;
constexpr size_t OFF_G = OFF_V + (size_t)MT * 1024 * 2;
constexpr size_t OFF_GA = OFF_G + (size_t)ML * 1024 * 2;
constexpr size_t OFF_U = OFF_GA + (size_t)ML * 1024 * 2;
constexpr size_t OFF_CB = OFF_U + (size_t)ML * 1024 * 2;
constexpr size_t OFF_GB = OFF_CB + (size_t)ML * 1024 * 2;
constexpr size_t OFF_BAR = OFF_GB + (size_t)NB * 4 * NCH * 256 * 64 * 2;
constexpr size_t BAR_BYTES = 16384;
constexpr size_t WS_NEED = OFF_BAR + BAR_BYTES;
constexpr size_t OFF_ROWSS = OFF_DD;
constexpr size_t OFF_BIAS2 = OFF_DD + 262144;

struct Params {
    const float *x, *c, *ctx, *c_ctx, *w_ada, *b_ada, *g_mix, *w_in, *w_dec_up, *b_dec, *g_head, *w_gla_out, *w_conv, *w_conv_out,
        *w_mix_out, *g_ffn, *w_ffn_in, *w_ffn_out, *g_final;
    float* out;
    unsigned char* ws;
};

typedef __bf16 bf16v2_t __attribute__((ext_vector_type(2)));
typedef float f32x2_t __attribute__((ext_vector_type(2)));
__device__ __forceinline__ unsigned pk_bf16(float lo, float hi) { const f32x2_t v = {lo, hi}; const bf16v2_t b = __builtin_convertvector(v, bf16v2_t); return __builtin_bit_cast(unsigned, b); }
__device__ __forceinline__ float bf_lo(unsigned w) { return __uint_as_float(w << 16); }
__device__ __forceinline__ float bf_hi(unsigned w) { return __uint_as_float(w & 0xffff0000u); }
__device__ __forceinline__ float bf2f(bf16_t b) { return __uint_as_float(((unsigned)b) << 16); }
__device__ __forceinline__ bf16_t f2bf(float f) { return (bf16_t)(pk_bf16(f, 0.f) & 0xffffu); }
__device__ __forceinline__ float wave_sum(float v) {
#pragma unroll
    for (int o = 32; o > 0; o >>= 1) v += __shfl_xor(v, o);
    return v;
}
__device__ __forceinline__ float sigmoidf_(float v) { return __builtin_amdgcn_rcpf(1.f + __expf(-v)); }


#define XB_TMO      128
#define XB_XCNT(j)  (256  + 64 * (j))
#define XB_XSUB(j)  (1280 + 64 * (j))
#define XB_XGEN(j)  (2304 + 64 * (j))
#define XB_TOP      3328
#define XB_TOPGEN   3392
#define XCD_BAR_WORDS 3456
#define XB_SPIN_CAP (1u << 18)
__device__ __forceinline__ unsigned xb_ld(unsigned* p)              { return __hip_atomic_load(p, __ATOMIC_RELAXED, __HIP_MEMORY_SCOPE_AGENT); }
__device__ __forceinline__ unsigned xb_add(unsigned* p, unsigned v) { return __hip_atomic_fetch_add(p, v, __ATOMIC_RELAXED, __HIP_MEMORY_SCOPE_AGENT); }
__device__ __forceinline__ unsigned xb_xcc_id() { return (unsigned)__builtin_amdgcn_s_getreg((3 << 11) | 20) & 0xFu; }
#define XB_SPIN(cond, bar) do { unsigned _sp = 0; while (cond) { __builtin_amdgcn_s_sleep(1); \
    if ((++_sp & 255u) == 0u) { if (xb_ld(&(bar)[XB_TMO])) break; if (_sp > XB_SPIN_CAP) { atomicAdd(&(bar)[XB_TMO], 1u); break; } } } } while (0)
struct XcdBarrier { unsigned* bar; unsigned x; volatile LAS unsigned* st; };
__device__ __forceinline__ XcdBarrier xcd_barrier_post(unsigned* bar, volatile LAS unsigned* st) {
    XcdBarrier b; b.bar = bar; b.x = xb_xcc_id(); b.st = st;
    if (threadIdx.x == 0) (void)xb_add(&bar[XB_XCNT(b.x)], 1u);
    return b;
}
__device__ __forceinline__ void xcd_barrier_complete(unsigned* bar, unsigned x, unsigned& nloc, unsigned& nx) {
    const unsigned G = gridDim.x * gridDim.y * gridDim.z;
    unsigned sum, cnt, mine, sp = 0u;
    for (;;) {
        sum = 0u; cnt = 0u; mine = 0u;
#pragma unroll
        for (unsigned j = 0; j < 16; ++j) { const unsigned c = xb_ld(&bar[XB_XCNT(j)]); sum += c; cnt += (c > 0u) ? 1u : 0u; mine = (j == x) ? c : mine; }
        if (sum == G) break;
        __builtin_amdgcn_s_sleep(1);
        if ((++sp & 255u) == 0u) { if (xb_ld(&bar[XB_TMO])) break; if (sp > XB_SPIN_CAP) { atomicAdd(&bar[XB_TMO], 1u); break; } }
    }
    nloc = mine > 0u ? mine : 1u; nx = cnt > 0u ? cnt : 1u;
}
__device__ __forceinline__ void xcd_barrier(const XcdBarrier& b) {
    asm volatile("s_waitcnt vmcnt(0)" ::: "memory");
    __syncthreads();
    if (threadIdx.x == 0) {
        unsigned* bar = b.bar;
        __builtin_amdgcn_s_waitcnt(0);
        unsigned nloc = b.st[0], nx = b.st[1];
        if (nloc == 0u) { xcd_barrier_complete(bar, b.x, nloc, nx); b.st[0] = nloc; b.st[1] = nx; }
        const unsigned old = xb_add(&bar[XB_XSUB(b.x)], 1u);
        const unsigned gen = old / nloc;
        if (old + 1u == (gen + 1u) * nloc) {
            __builtin_amdgcn_fence(__ATOMIC_RELEASE, "agent");
            asm volatile("s_waitcnt vmcnt(0)" ::: "memory");
            const unsigned og = xb_add(&bar[XB_TOP], 1u);
            const unsigned tg = og / nx;
            if (og + 1u == (tg + 1u) * nx) xb_add(&bar[XB_TOPGEN], 1u);
            else XB_SPIN(xb_ld(&bar[XB_TOPGEN]) == tg, bar);
            __builtin_amdgcn_fence(__ATOMIC_ACQUIRE, "agent");
            xb_add(&bar[XB_XGEN(b.x)], 1u);
            asm volatile("s_waitcnt vmcnt(0)" ::: "memory");
        } else {
            XB_SPIN(xb_ld(&bar[XB_XGEN(b.x)]) == gen, bar);
            __builtin_amdgcn_fence(__ATOMIC_ACQUIRE, "agent");
            asm volatile("s_waitcnt vmcnt(0)" ::: "memory");
        }
    }
    __syncthreads();
}

namespace pg8 {
constexpr int BM = 256, BK = 64, HALF = 128, HTB = HALF * BK * 2, NXCD = 8, WGM = 2;
__device__ __forceinline__ int lds_byte(int r, int c) { const int st = (r >> 4) * 2 + (c >> 5), rr = r & 15, cc = c & 31, ob = rr * 64 + cc * 2; return st * 1024 + (ob ^ (((ob >> 9) & 1) << 5)); }
__device__ __forceinline__ void stage_rc(int b, int& R, int& C) { const int st = b / 1024, sb = b % 1024, swz = sb ^ (((sb >> 9) & 1) << 5); R = (st >> 1) * 16 + swz / 64; C = (st & 1) * 32 + (swz % 64) / 2; }
__device__ __forceinline__ int perm32(int rho) { const int n = rho >> 4, i = rho & 15; return 8 * (i >> 2) + 4 * n + (i & 3); }
struct Unit { int pm, pn, kind; };
struct Gemm { const bf16_t* A; const bf16_t* Bt; int M, N, K, nt; };

struct StaticOrder {
    int nM, nN, nwg, G, c;
    __device__ void init(int M, int N, int G_, int c_) { nM = M / BM; nN = N / BM; nwg = nM * nN; G = G_; c = c_; }
    __device__ bool next(int i, Unit& u) const {
        const long L = (long)i * G + c; if (L >= nwg) return false;
        int wgid = (int)L; { const int q = nwg / NXCD, r = nwg % NXCD, xcd = wgid % NXCD, off = wgid / NXCD; wgid = (xcd < r ? xcd * (q + 1) : r * (q + 1) + (xcd - r) * q) + off; }
        const int nig = WGM * nN, gid = wgid / nig, fm = gid * WGM, gsz = (nM - fm) < WGM ? (nM - fm) : WGM;
        u.pm = fm + ((wgid % nig) % gsz); u.pn = (wgid % nig) / gsz; u.kind = 0; return true;
    }
};
struct DualOrder {
    StaticOrder so;
    __device__ void init(int M, int N, int G_, int c_) { so.init(M, N, G_, c_); }
    __device__ bool next(int i, Unit& u) const { if (!so.next(i >> 1, u)) return false; u.kind = i & 1; return true; }
};
struct InOrder {
    StaticOrder so;
    __device__ void init(int G_, int c_) { so.init(ML, NINP, G_, c_); }
    __device__ bool next(int i, Unit& u) const {
        const long L = (long)i * so.G + so.c;
        if (L < so.nwg) return so.next(i, u);
        const int j = (int)(L - so.nwg); if (j >= 56) return false;
        u.pm = 128 + j / 7; const int cc = j % 7; u.pn = cc < 2 ? 2 + cc : (cc < 6 ? 4 + (cc - 2) : 32); u.kind = 0; return true;
    }
};

template <class Epi, class Sched>
__device__ __forceinline__ void gemm_phase(LAS unsigned char* lds, const Gemm g, const Sched& S, const Epi& E) {
    const int tid = threadIdx.x, wid = __builtin_amdgcn_readfirstlane(tid >> 6), lane = tid & 63, wr = wid >> 2, wc = wid & 3, fr = lane & 15, fq = lane >> 4;
    const int K = g.K, nt = g.nt;
    unsigned voffA[2], voffB[2];
#pragma unroll
    for (int i = 0; i < 2; ++i) { int R, C; stage_rc(tid * 16 + i * 8192, R, C); const int Rb = Epi::PERM ? ((R & ~31) + perm32(R & 31)) : R;
        voffA[i] = (unsigned)(R * K + C) * 2u; voffB[i] = (unsigned)(Rb * K + C) * 2u; }
    const size_t kstep = (size_t)(BK * 2);
    const size_t hstep = (size_t)HALF * K * 2;
    const size_t tstep = 2 * hstep;
    const unsigned ldsw = (unsigned)wid * 1024u;
    const int aoff = lds_byte(wr * 64 + fr, fq * 8), boff = lds_byte(wc * 32 + fr, fq * 8);
#define PG8_SA(b, h) (((b) * 2 + (h)) * HTB)
#define PG8_SB(b, h) ((4 + (b) * 2 + (h)) * HTB)
#define PG8_STAGE(bufoff, gbase, voff) do { _Pragma("unroll") for (int _i = 0; _i < 2; ++_i) \
        __builtin_amdgcn_global_load_lds((const unsigned*)((const char*)(gbase) + (voff)[_i]), (LAS unsigned*)(lds + (bufoff) + ldsw + _i * 8192), 16, 0, 0); } while (0)
#define PG8_LDA(dst, b, h) do { _Pragma("unroll") for (int m = 0; m < 4; ++m) _Pragma("unroll") for (int k = 0; k < 2; ++k) dst[m][k] = *(const LAS bf16x8*)(lds + PG8_SA(b, h) + aoff + m * 2048 + k * 1024); } while (0)
#define PG8_LDB(dst, b, h) do { _Pragma("unroll") for (int n = 0; n < 2; ++n) _Pragma("unroll") for (int k = 0; k < 2; ++k) dst[n][k] = *(const LAS bf16x8*)(lds + PG8_SB(b, h) + boff + n * 2048 + k * 1024); } while (0)
#define PG8_MMA(ai, bj, At, Bt) do { __builtin_amdgcn_s_setprio(1); _Pragma("unroll") for (int m = 0; m < 4; ++m) _Pragma("unroll") for (int n = 0; n < 2; ++n) _Pragma("unroll") for (int k = 0; k < 2; ++k) \
        acc[ai][bj][m][n] = __builtin_amdgcn_mfma_f32_16x16x32_bf16(Bt[n][k], At[m][k], acc[ai][bj][m][n], 0, 0, 0); __builtin_amdgcn_s_setprio(0); } while (0)
#define PG8_WAIT_V(n) asm volatile("s_waitcnt vmcnt(" #n ")" ::: "memory")
#define PG8_WAIT_L(n) asm volatile("s_waitcnt lgkmcnt(" #n ")" ::: "memory")
#define PG8_BAR __builtin_amdgcn_s_barrier()
#define PG8_SCHED __builtin_amdgcn_sched_barrier(0)
    Unit cur, nxt; int ui = 0;
    if (!S.next(0, cur)) return;
    f32x4 acc[2][2][4][2];
#pragma unroll
    for (int a = 0; a < 2; ++a)
#pragma unroll
        for (int b = 0; b < 2; ++b)
#pragma unroll
            for (int m = 0; m < 4; ++m)
#pragma unroll
                for (int n = 0; n < 2; ++n) acc[a][b][m][n] = (f32x4){0.f, 0.f, 0.f, 0.f};
    bf16x8 At[4][2], B0[2][2], B1[2][2];
#define PG8_UA(u) ((const char*)g.A + (size_t)(u).pm * tstep + ((Epi::DUAL && (u).kind) ? Epi::DA2 : 0l))
#define PG8_UB(u) ((const char*)g.Bt + (size_t)(u).pn * tstep + ((Epi::DUAL && (u).kind) ? Epi::DB2 : 0l))
    const char* cA = PG8_UA(cur); const char* cB = PG8_UB(cur);
    PG8_STAGE(PG8_SB(0, 0), cB, voffB); PG8_STAGE(PG8_SA(0, 0), cA, voffA); PG8_STAGE(PG8_SB(0, 1), cB + hstep, voffB); PG8_STAGE(PG8_SA(0, 1), cA + hstep, voffA);
    if (wr == 1) PG8_BAR;
    PG8_WAIT_V(4); PG8_BAR;
    PG8_STAGE(PG8_SB(1, 0), cB + kstep, voffB); PG8_STAGE(PG8_SA(1, 0), cA + kstep, voffA); PG8_STAGE(PG8_SB(1, 1), cB + hstep + kstep, voffB);
    PG8_WAIT_V(6); PG8_BAR;
    for (;;) {
        const bool has_next = S.next(ui + 1, nxt);
        const char* nA = has_next ? PG8_UA(nxt) : cA; const char* nB = has_next ? PG8_UB(nxt) : cB;
#define PG8_ITER(t) do { \
            const bool last = (t == nt - 2); \
            const char* a1 = cA + (size_t)(t + 1) * kstep; \
            const char* a2 = last ? nA : cA + (size_t)(t + 2) * kstep; \
            const char* b2 = last ? nB : cB + (size_t)(t + 2) * kstep; \
            const char* a3 = a2 + kstep; const char* b3 = b2 + kstep; \
            PG8_LDB(B0, 0, 0); PG8_SCHED; PG8_LDA(At, 0, 0); PG8_STAGE(PG8_SA(1, 1), a1 + hstep, voffA); \
            PG8_WAIT_L(8); PG8_BAR; PG8_WAIT_L(0); PG8_MMA(0, 0, At, B0); PG8_BAR; PG8_SCHED; \
            PG8_LDB(B1, 0, 1); PG8_STAGE(PG8_SB(0, 0), b2, voffB); \
            PG8_BAR; PG8_WAIT_L(0); PG8_MMA(0, 1, At, B1); PG8_BAR; \
            PG8_LDA(At, 0, 1); PG8_STAGE(PG8_SA(0, 0), a2, voffA); \
            PG8_BAR; PG8_WAIT_L(0); PG8_MMA(1, 0, At, B0); PG8_BAR; PG8_SCHED; \
            PG8_STAGE(PG8_SB(0, 1), b2 + hstep, voffB); \
            PG8_WAIT_V(6); PG8_BAR; PG8_MMA(1, 1, At, B1); PG8_BAR; \
            PG8_LDB(B0, 1, 0); PG8_SCHED; PG8_LDA(At, 1, 0); PG8_STAGE(PG8_SA(0, 1), a2 + hstep, voffA); \
            PG8_WAIT_L(8); PG8_BAR; PG8_WAIT_L(0); PG8_MMA(0, 0, At, B0); PG8_BAR; PG8_SCHED; \
            PG8_LDB(B1, 1, 1); PG8_STAGE(PG8_SB(1, 0), b3, voffB); \
            PG8_BAR; PG8_WAIT_L(0); PG8_MMA(0, 1, At, B1); PG8_BAR; \
            PG8_LDA(At, 1, 1); PG8_STAGE(PG8_SA(1, 0), a3, voffA); \
            PG8_BAR; PG8_WAIT_L(0); PG8_MMA(1, 0, At, B0); PG8_BAR; PG8_SCHED; \
            PG8_STAGE(PG8_SB(1, 1), b3 + hstep, voffB); \
            PG8_WAIT_V(6); PG8_BAR; PG8_MMA(1, 1, At, B1); PG8_BAR; \
        } while (0)
        for (int t = 0; t < nt; t += 2) PG8_ITER(t);
#undef PG8_ITER
        bool keep = false;
        if constexpr (Epi::DUAL) keep = E(acc, cur, wr, wc, fr, fq); else E(acc, cur, wr, wc, fr, fq);
        if (!has_next) break;
        if (!keep) {
#pragma unroll
            for (int a = 0; a < 2; ++a)
#pragma unroll
                for (int b = 0; b < 2; ++b)
#pragma unroll
                    for (int m = 0; m < 4; ++m)
#pragma unroll
                        for (int n = 0; n < 2; ++n) acc[a][b][m][n] = (f32x4){0.f, 0.f, 0.f, 0.f};
        }
        cur = nxt; cA = nA; cB = nB; ++ui;
    }
    PG8_WAIT_V(0);
    if (wr == 0) PG8_BAR;
    PG8_BAR;
#undef PG8_UA
#undef PG8_UB
#undef PG8_SA
#undef PG8_SB
#undef PG8_STAGE
#undef PG8_LDA
#undef PG8_LDB
#undef PG8_MMA
#undef PG8_WAIT_V
#undef PG8_WAIT_L
#undef PG8_BAR
#undef PG8_SCHED
}
}
using pg8::Unit;

template <int CTRL> __device__ __forceinline__ float dpp_row(float v) { return __builtin_bit_cast(float, __builtin_amdgcn_update_dpp(0, __builtin_bit_cast(int, v), CTRL, 0xF, 0xF, false)); }
struct EpiInProj {
    static constexpr bool PERM = true, DUAL = false; static constexpr int NT1 = 0; static constexpr long DA2 = 0, DB2 = 0;
    bf16_t *q, *k, *v, *g, *aconv, *ga, *gb; float* dd; const float* wconv;
    __device__ __forceinline__ void operator()(const f32x4 (&acc)[2][2][4][2], const Unit& un, int wr, int wc, int fr, int fq) const {
        const int pn = un.pn; const size_t row0 = (size_t)un.pm * 256 + wr * 64 + fr;
        if (pn < 12 || (pn >= 28 && pn < 32)) {
            bf16_t* base; int ldc, colt, act;
            if (pn < 2) { base = q; ldc = 512; colt = pn * 256; act = 0; }
            else if (pn < 4) { base = k; ldc = 512; colt = (pn - 2) * 256; act = 0; }
            else if (pn < 8) { base = v; ldc = 1024; colt = (pn - 4) * 256; act = 0; }
            else if (pn < 12) { base = g; ldc = 1024; colt = (pn - 8) * 256; act = 1; }
            else { base = ga; ldc = 1024; colt = (pn - 28) * 256; act = 2; }
            const int col0 = colt + wc * 32 + 8 * fq;
#pragma unroll
            for (int ai = 0; ai < 2; ++ai)
#pragma unroll
                for (int m = 0; m < 4; ++m) { bf16_t* rowp = base + (row0 + ai * 128 + m * 16) * ldc + col0;
#pragma unroll
                    for (int bj = 0; bj < 2; ++bj) { f32x4 v0 = acc[ai][bj][m][0], v1 = acc[ai][bj][m][1];
                        if (act) {
#pragma unroll
                            for (int j = 0; j < 4; ++j) { const float s0 = sigmoidf_(v0[j]), s1 = sigmoidf_(v1[j]); v0[j] = act == 1 ? v0[j] * s0 : s0; v1[j] = act == 1 ? v1[j] * s1 : s1; } }
                        u32x4 w; w.x = pk_bf16(v0[0], v0[1]); w.y = pk_bf16(v0[2], v0[3]); w.z = pk_bf16(v1[0], v1[1]); w.w = pk_bf16(v1[2], v1[3]);
                        *(u32x4*)(rowp + bj * 128) = w; } }
        } else if (pn < 28) {
            const int chb = 64 * (pn - 12) + 16 * wc + 4 * fq;
            const f32x4 w0 = *(const f32x4*)(wconv + chb), w1 = *(const f32x4*)(wconv + 1024 + chb), w2 = *(const f32x4*)(wconv + 2048 + chb);
            const f32x4 zero = {0.f, 0.f, 0.f, 0.f};
#pragma unroll
            for (int ai = 0; ai < 2; ++ai) {
                f32x4 u[4], A[4], C[4];
#pragma unroll
                for (int m = 0; m < 4; ++m) { u[m] = acc[ai][0][m][1] * acc[ai][1][m][0];
#pragma unroll
                    for (int j = 0; j < 4; ++j) { A[m][j] = dpp_row<0x121>(u[m][j]); C[m][j] = dpp_row<0x12F>(u[m][j]); } }
#pragma unroll
                for (int m = 0; m < 4; ++m) {
                    const f32x4 prev = fr > 0 ? A[m] : (m > 0 ? A[m > 0 ? m - 1 : 0] : zero), next = fr < 15 ? C[m] : (m < 3 ? C[m < 3 ? m + 1 : 3] : zero);
                    const f32x4 uc = w0 * prev + w1 * u[m] + w2 * next, ac = acc[ai][0][m][0] * uc, gv = acc[ai][1][m][1];
                    const size_t off = (row0 + ai * 128 + m * 16) * 1024 + chb;
                    u32x2 wa; wa.x = pk_bf16(ac[0], ac[1]); wa.y = pk_bf16(ac[2], ac[3]); *(u32x2*)(aconv + off) = wa;
                    u32x2 wg; wg.x = pk_bf16(sigmoidf_(gv[0]), sigmoidf_(gv[1])); wg.y = pk_bf16(sigmoidf_(gv[2]), sigmoidf_(gv[3])); *(u32x2*)(gb + off) = wg;
                }
            }
        } else {
            if (wc == 0) {
#pragma unroll
                for (int ai = 0; ai < 2; ++ai)
#pragma unroll
                    for (int m = 0; m < 4; ++m) { float* rp = dd + (row0 + ai * 128 + m * 16) * 32 + 8 * fq;
                        *(f32x4*)rp = acc[ai][0][m][0]; *(f32x4*)(rp + 4) = acc[ai][0][m][1]; }
            }
        }
    }
};
template <int MODE> struct EpiGate {
    static constexpr bool PERM = true, DUAL = false; static constexpr int NT1 = 0; static constexpr long DA2 = 0, DB2 = 0;
    bf16_t* T; const bf16_t* sg;
    __device__ __forceinline__ void operator()(const f32x4 (&acc)[2][2][4][2], const Unit& un, int wr, int wc, int fr, int fq) const {
        const size_t row0 = (size_t)un.pm * 256 + wr * 64 + fr; const int col0 = un.pn * 256 + wc * 32 + 8 * fq;
#pragma unroll
        for (int ai = 0; ai < 2; ++ai)
#pragma unroll
            for (int m = 0; m < 4; ++m)
#pragma unroll
                for (int bj = 0; bj < 2; ++bj) { const size_t off = (row0 + ai * 128 + m * 16) * 1024 + col0 + bj * 128;
                    const u32x4 s = *(const u32x4*)(sg + off); const f32x4 a0 = acc[ai][bj][m][0], a1 = acc[ai][bj][m][1];
                    float o[8] = {a0[0] * bf_lo(s.x), a0[1] * bf_hi(s.x), a0[2] * bf_lo(s.y), a0[3] * bf_hi(s.y), a1[0] * bf_lo(s.z), a1[1] * bf_hi(s.z), a1[2] * bf_lo(s.w), a1[3] * bf_hi(s.w)};
                    if (MODE == 1) { const u32x4 t = *(const u32x4*)(T + off);
                        o[0] += bf_lo(t.x); o[1] += bf_hi(t.x); o[2] += bf_lo(t.y); o[3] += bf_hi(t.y); o[4] += bf_lo(t.z); o[5] += bf_hi(t.z); o[6] += bf_lo(t.w); o[7] += bf_hi(t.w); }
                    u32x4 w; w.x = pk_bf16(o[0], o[1]); w.y = pk_bf16(o[2], o[3]); w.z = pk_bf16(o[4], o[5]); w.w = pk_bf16(o[6], o[7]);
                    *(u32x4*)(T + off) = w; }
    }
};
struct EpiDual {
    static constexpr bool PERM = true, DUAL = true; static constexpr int NT1 = 16;
    static constexpr long DA2 = (long)OFF_G - (long)OFF_CB, DB2 = (long)OFF_WGLA - (long)OFF_WCONV;
    bf16_t* T; const bf16_t* sga; const bf16_t* sgb;
    __device__ __forceinline__ bool operator()(f32x4 (&acc)[2][2][4][2], const Unit& un, int wr, int wc, int fr, int fq) const {
        const unsigned lo = (unsigned)(fr * 2048 + fq * 16);
        const size_t ub = ((size_t)un.pm * 256 + wr * 64) * 2048 + ((size_t)un.pn * 256 + wc * 32) * 2;
        const char* pa = (const char*)sga + ub;
        if (un.kind == 0) {
            const char* pb = (const char*)sgb + ub;
#pragma unroll
            for (int ai = 0; ai < 2; ++ai)
#pragma unroll
                for (int mh = 0; mh < 2; ++mh) {
                    u32x4 a[2][2], b[2][2];
#pragma unroll
                    for (int mm = 0; mm < 2; ++mm)
#pragma unroll
                        for (int bj = 0; bj < 2; ++bj) { const int cb_ = (ai * 128 + (2 * mh + mm) * 16) * 2048 + bj * 256; a[mm][bj] = *(const u32x4*)(pa + cb_ + lo); b[mm][bj] = *(const u32x4*)(pb + cb_ + lo); }
#pragma unroll
                    for (int mm = 0; mm < 2; ++mm)
#pragma unroll
                        for (int bj = 0; bj < 2; ++bj) { const int m = 2 * mh + mm;
#pragma unroll
                            for (int e = 0; e < 4; ++e) { const float r0 = bf_lo(b[mm][bj][e]) * __builtin_amdgcn_rcpf(fmaxf(bf_lo(a[mm][bj][e]), 1e-30f)), r1 = bf_hi(b[mm][bj][e]) * __builtin_amdgcn_rcpf(fmaxf(bf_hi(a[mm][bj][e]), 1e-30f));
                                acc[ai][bj][m][e >> 1][2 * (e & 1)] *= r0; acc[ai][bj][m][e >> 1][2 * (e & 1) + 1] *= r1; } }
                    asm volatile("" ::: "memory");
                }
            return true;
        }
        char* pt = (char*)T + ub;
#pragma unroll
        for (int ai = 0; ai < 2; ++ai)
#pragma unroll
            for (int m = 0; m < 4; ++m)
#pragma unroll
                for (int bj = 0; bj < 2; ++bj) { const int cb_ = (ai * 128 + m * 16) * 2048 + bj * 256;
                    const u32x4 s = *(const u32x4*)(pa + cb_ + lo); const f32x4 a0 = acc[ai][bj][m][0], a1 = acc[ai][bj][m][1];
                    u32x4 w; w.x = pk_bf16(a0[0] * bf_lo(s.x), a0[1] * bf_hi(s.x)); w.y = pk_bf16(a0[2] * bf_lo(s.y), a0[3] * bf_hi(s.y));
                    w.z = pk_bf16(a1[0] * bf_lo(s.z), a1[1] * bf_hi(s.z)); w.w = pk_bf16(a1[2] * bf_lo(s.w), a1[3] * bf_hi(s.w));
                    *(u32x4*)(pt + cb_ + lo) = w; }
        return false;
    }
};
struct EpiRes {
    static constexpr bool PERM = true, DUAL = false; static constexpr int NT1 = 0; static constexpr long DA2 = 0, DB2 = 0;
    const float* xin; float* out; const float* gate;
    __device__ __forceinline__ void operator()(const f32x4 (&acc)[2][2][4][2], const Unit& un, int wr, int wc, int fr, int fq) const {
        const size_t row0 = (size_t)un.pm * 256 + wr * 64 + fr; const int col0 = un.pn * 256 + wc * 32 + 8 * fq;
        const float* gp = gate + (size_t)(un.pm >> 4) * 6144 + col0;
        f32x4 gv[2][2];
#pragma unroll
        for (int bj = 0; bj < 2; ++bj)
#pragma unroll
            for (int n = 0; n < 2; ++n) gv[bj][n] = *(const f32x4*)(gp + bj * 128 + 4 * n);
#pragma unroll
        for (int ai = 0; ai < 2; ++ai)
#pragma unroll
            for (int m = 0; m < 4; ++m)
#pragma unroll
                for (int bj = 0; bj < 2; ++bj)
#pragma unroll
                    for (int n = 0; n < 2; ++n) { const size_t off = (row0 + ai * 128 + m * 16) * 1024 + col0 + bj * 128 + 4 * n;
                        const f32x4 xv = *(const f32x4*)(xin + off); *(f32x4*)(out + off) = xv + gv[bj][n] * acc[ai][bj][m][n]; }
    }
};
struct EpiMix {
    static constexpr bool PERM = true, DUAL = false; static constexpr int NT1 = 0; static constexpr long DA2 = 0, DB2 = 0;
    const float* xin; float* out; const float* mod; const float* gffn; bf16_t* A2; float* rowss;
    __device__ __forceinline__ void operator()(const f32x4 (&acc)[2][2][4][2], const Unit& un, int wr, int wc, int fr, int fq) const {
        const size_t row0 = (size_t)un.pm * 256 + wr * 64 + fr; const int col0 = un.pn * 256 + wc * 32 + 8 * fq;
        const float* mp = mod + (size_t)(un.pm >> 4) * 6144 + col0;
        f32x4 gv[2][2], gam[2][2];
#pragma unroll
        for (int bj = 0; bj < 2; ++bj)
#pragma unroll
            for (int n = 0; n < 2; ++n) { gv[bj][n] = *(const f32x4*)(mp + 2048 + bj * 128 + 4 * n);
                gam[bj][n] = *(const f32x4*)(gffn + col0 + bj * 128 + 4 * n) * (*(const f32x4*)(mp + 4096 + bj * 128 + 4 * n) + 1.f); }
#pragma unroll
        for (int ai = 0; ai < 2; ++ai)
#pragma unroll
            for (int m = 0; m < 4; ++m) { const size_t rowb = (row0 + ai * 128 + m * 16) * 1024 + col0; float ss = 0.f;
#pragma unroll
                for (int bj = 0; bj < 2; ++bj) { f32x4 o[2];
#pragma unroll
                    for (int n = 0; n < 2; ++n) { const size_t off = rowb + bj * 128 + 4 * n; o[n] = *(const f32x4*)(xin + off) + gv[bj][n] * acc[ai][bj][m][n]; *(f32x4*)(out + off) = o[n];
#pragma unroll
                        for (int j = 0; j < 4; ++j) ss += o[n][j] * o[n][j]; }
                    const f32x4 a0 = o[0] * gam[bj][0], a1 = o[1] * gam[bj][1];
                    u32x4 w; w.x = pk_bf16(a0[0], a0[1]); w.y = pk_bf16(a0[2], a0[3]); w.z = pk_bf16(a1[0], a1[1]); w.w = pk_bf16(a1[2], a1[3]);
                    *(u32x4*)(A2 + rowb + bj * 128) = w; }
                ss += __shfl_xor(ss, 16); ss += __shfl_xor(ss, 32);
                if (fq == 0) (void)__hip_atomic_fetch_add(rowss + (row0 + ai * 128 + m * 16), ss, __ATOMIC_RELAXED, __HIP_MEMORY_SCOPE_AGENT); }
    }
};
struct EpiFfnIn {
    static constexpr bool PERM = true, DUAL = false; static constexpr int NT1 = 0; static constexpr long DA2 = 0, DB2 = 0;
    bf16_t* s; const float* rowss; const float* bias2;
    __device__ __forceinline__ void operator()(const f32x4 (&acc)[2][2][4][2], const Unit& un, int wr, int wc, int fr, int fq) const {
        const size_t row0 = (size_t)un.pm * 256 + wr * 64 + fr; const int col0 = un.pn * 128 + wc * 32 + 8 * fq;
        const float* bp = bias2 + (size_t)(un.pm >> 4) * (2 * DFF) + un.pn * 256 + wc * 32 + 8 * fq;
        f32x4 ba[2], bb[2]; float rs[2][4];
#pragma unroll
        for (int n = 0; n < 2; ++n) { ba[n] = *(const f32x4*)(bp + 4 * n); bb[n] = *(const f32x4*)(bp + 128 + 4 * n); }
#pragma unroll
        for (int ai = 0; ai < 2; ++ai)
#pragma unroll
            for (int m = 0; m < 4; ++m) rs[ai][m] = rsqrtf(rowss[row0 + ai * 128 + m * 16] * (1.f / 1024.f) + 1e-6f);
#pragma unroll
        for (int ai = 0; ai < 2; ++ai)
#pragma unroll
            for (int m = 0; m < 4; ++m) { float o[8];
#pragma unroll
                for (int n = 0; n < 2; ++n)
#pragma unroll
                    for (int j = 0; j < 4; ++j) { const float a = rs[ai][m] * acc[ai][0][m][n][j] + ba[n][j], b = rs[ai][m] * acc[ai][1][m][n][j] + bb[n][j]; o[4 * n + j] = a * sigmoidf_(a) * b; }
                u32x4 w; w.x = pk_bf16(o[0], o[1]); w.y = pk_bf16(o[2], o[3]); w.z = pk_bf16(o[4], o[5]); w.w = pk_bf16(o[6], o[7]);
                *(u32x4*)(s + (row0 + ai * 128 + m * 16) * DFF + col0) = w; }
    }
};

__device__ __forceinline__ void adaln_item(const Params& p, LAS unsigned char* lds, int it) {
    const int tid = threadIdx.x, lane = tid & 63, wid = tid >> 6;
    LAS float* sl = (LAS float*)lds;
    LAS float* red = sl + 9 * 1024;
    for (int i = tid; i < 9 * 1024; i += 512) { const int r = i >> 10, k = i & 1023; const float cv = r < 8 ? p.c[r * 1024 + k] : p.c_ctx[k]; sl[i] = cv / (1.f + __expf(-cv)); }
    __syncthreads();
    const int c0 = 32 * it, kg = tid >> 3, cq = tid & 7;
    float acc[9][4];
#pragma unroll
    for (int r = 0; r < 9; ++r)
#pragma unroll
        for (int j = 0; j < 4; ++j) acc[r][j] = 0.f;
    f32x4 wk[16];
#pragma unroll
    for (int kk = 0; kk < 16; ++kk) wk[kk] = *(const f32x4*)(p.w_ada + (size_t)(kg * 16 + kk) * 6144 + c0 + 4 * cq);
#pragma unroll
    for (int kk = 0; kk < 16; ++kk) { const int k = kg * 16 + kk;
#pragma unroll
        for (int r = 0; r < 9; ++r) { const float s = sl[r * 1024 + k];
#pragma unroll
            for (int j = 0; j < 4; ++j) acc[r][j] += s * wk[kk][j]; } }
#pragma unroll
    for (int r = 0; r < 9; ++r)
#pragma unroll
        for (int j = 0; j < 4; ++j) { float v = acc[r][j]; v += __shfl_xor(v, 8); v += __shfl_xor(v, 16); v += __shfl_xor(v, 32); acc[r][j] = v; }
    if ((lane >> 3) == 0) {
#pragma unroll
        for (int r = 0; r < 9; ++r)
#pragma unroll
            for (int j = 0; j < 4; ++j) red[(wid * 9 + r) * 32 + 4 * cq + j] = acc[r][j]; }
    __syncthreads();
    if (tid < 288) { const int r = tid >> 5, cc = tid & 31; float s = 0.f;
#pragma unroll
        for (int w = 0; w < 8; ++w) s += red[(w * 9 + r) * 32 + cc];
        ((float*)(p.ws + OFF_MOD))[r * 6144 + c0 + cc] = s + p.b_ada[c0 + cc]; }
}
struct WTile { const float* src; bf16_t* dst; int sld, dld, n0, k0, srccol, nvalid, mode; };
__device__ __forceinline__ int win_src(int R) {
    const int pn = R >> 8, c = R & 255;
    if (pn < 12) return R;
    if (pn < 28) { const int T = pn - 12, bj = c >> 7, wc = (c >> 5) & 3, fq = (c >> 3) & 3, n = (c >> 2) & 1, j = c & 3, ch64 = 16 * wc + 4 * fq + j;
        const int base = bj == 0 ? (n == 0 ? 3104 : 4128) : (n == 0 ? 5152 : 7200); return base + 64 * T + ch64; }
    if (pn < 32) return 6176 + (R - 28 * 256);
    return c < 32 ? 3072 + c : -1;
}
__device__ __forceinline__ WTile wconv_decode(const Params& p, int j) {
    WTile t; int nt, kt; t.nvalid = 64; t.mode = 0;
    if (j < 2112) { nt = j >> 4; kt = j & 15; t.src = p.w_in; t.sld = NIN; t.dst = (bf16_t*)(p.ws + OFF_WIN); t.dld = 1024; t.srccol = 0; t.mode = 1;
    } else if (j < 2880) { const int jj = j - 2112, mi = jj >> 8, r = jj & 255; nt = r >> 4; kt = r & 15; t.sld = 1024; t.dld = 1024; t.srccol = nt * 64;
        t.src = mi == 0 ? p.w_gla_out : (mi == 1 ? p.w_conv_out : p.w_mix_out); t.dst = (bf16_t*)(p.ws + (mi == 0 ? OFF_WGLA : (mi == 1 ? OFF_WCONV : OFF_WMIX)));
    } else if (j < 4288) { const int jj = j - 2880; nt = jj >> 4; kt = jj & 15; t.src = p.w_ffn_in; t.sld = 2 * DFF; t.dst = (bf16_t*)(p.ws + OFF_WFFI); t.dld = 1024;
        const int n0 = nt * 64, pt = n0 >> 8, w = n0 & 255; t.srccol = w < 128 ? 128 * pt + w : DFF + 128 * pt + (w - 128);
    } else { const int jj = j - 4288; nt = jj / 44; kt = jj % 44; t.src = p.w_ffn_out; t.sld = 1024; t.dst = (bf16_t*)(p.ws + OFF_WFFO); t.dld = DFF; t.srccol = nt * 64; }
    t.n0 = nt * 64; t.k0 = kt * 64; return t;
}
__device__ __forceinline__ void wconv_load(const WTile& t, f32x4 (&r)[2]) {
    const int tid = threadIdx.x, n4 = (tid & 15) * 4;
    const int sc = t.mode ? win_src(t.n0 + n4) : (n4 < t.nvalid ? t.srccol + n4 : -1);
#pragma unroll
    for (int i = 0; i < 2; ++i) { const int kk = (tid >> 4) + 32 * i; r[i] = sc >= 0 ? *(const f32x4*)(t.src + (size_t)(t.k0 + kk) * t.sld + sc) : (f32x4){0.f, 0.f, 0.f, 0.f}; }
}
__device__ void wconv_run(const Params& p, LAS unsigned char* lds, int jbeg, int jend) {
    const int tid = threadIdx.x;
    LAS float* tile = (LAS float*)lds;
    int j = jbeg + (int)blockIdx.x; if (j >= jend) return;
    WTile cur = wconv_decode(p, j); f32x4 r[2]; wconv_load(cur, r);
    for (;;) {
        const int jn = j + (int)gridDim.x; const bool more = jn < jend;
        { const int n4 = (tid & 15) * 4;
#pragma unroll
            for (int i = 0; i < 2; ++i) { const int kk = (tid >> 4) + 32 * i;
#pragma unroll
                for (int e = 0; e < 4; ++e) tile[kk * 65 + n4 + e] = r[i][e]; } }
        WTile nxt = cur; if (more) { nxt = wconv_decode(p, jn); wconv_load(nxt, r); }
        __syncthreads();
        { const int jr = tid >> 3, kg = tid & 7; float v[8];
#pragma unroll
            for (int e = 0; e < 8; ++e) v[e] = tile[(8 * kg + e) * 65 + jr];
            u32x4 w; w.x = pk_bf16(v[0], v[1]); w.y = pk_bf16(v[2], v[3]); w.z = pk_bf16(v[4], v[5]); w.w = pk_bf16(v[6], v[7]);
            *(u32x4*)(cur.dst + (size_t)(cur.n0 + jr) * cur.dld + cur.k0 + 8 * kg) = w; }
        __syncthreads();
        if (!more) break;
        cur = nxt; j = jn;
    }
}
constexpr int WT_MIX_END = 2112 + 768, WT_END = 2112 + 768 + 1408 + 704;
__device__ void phase_prep(const Params& p, LAS unsigned char* lds) {
    if (blockIdx.x < 192) { adaln_item(p, lds, blockIdx.x); __syncthreads(); }
    wconv_run(p, lds, 0, WT_MIX_END);
}

__device__ __forceinline__ void norm_mod_rows(const float* src0, const float* src1, int nrows0, int nrows, bf16_t* dst, const float* gw, const float* mod, int sh_off, int sc_off) {
    const int lane = threadIdx.x & 63, wid = threadIdx.x >> 6, RS = (int)gridDim.x * 8;
    for (int rowa = blockIdx.x * 8 + wid; rowa < nrows; rowa += 2 * RS) {
        const bool has2 = rowa + RS < nrows;
        int rows[2] = {rowa, has2 ? rowa + RS : rowa};
        f32x4 v[2][4];
#pragma unroll
        for (int u = 0; u < 2; ++u) { const int row = rows[u]; const float* s = row < nrows0 ? src0 + (size_t)row * 1024 : src1 + (size_t)(row - nrows0) * 1024;
            v[u][0] = *(const f32x4*)(s + 8 * lane); v[u][1] = *(const f32x4*)(s + 8 * lane + 4); v[u][2] = *(const f32x4*)(s + 512 + 8 * lane); v[u][3] = *(const f32x4*)(s + 512 + 8 * lane + 4); }
#pragma unroll
        for (int u = 0; u < 2; ++u) {
            if (u == 1 && !has2) break;
            const int row = rows[u]; const int mr = row < nrows0 ? row / SEQ : 8;
            float ss = 0.f;
#pragma unroll
            for (int i = 0; i < 4; ++i)
#pragma unroll
                for (int j = 0; j < 4; ++j) ss += v[u][i][j] * v[u][i][j];
            ss = wave_sum(ss);
            const float rs = rsqrtf(ss * (1.f / 1024.f) + 1e-6f);
            const float* mp = mod + (size_t)mr * 6144;
#pragma unroll
            for (int hh = 0; hh < 2; ++hh) { const int c = hh * 512 + 8 * lane; float o[8];
#pragma unroll
                for (int q = 0; q < 2; ++q) { const f32x4 gg = *(const f32x4*)(gw + c + 4 * q), sc = *(const f32x4*)(mp + sc_off + c + 4 * q), sh = *(const f32x4*)(mp + sh_off + c + 4 * q);
#pragma unroll
                    for (int j = 0; j < 4; ++j) o[4 * q + j] = (v[u][2 * hh + q][j] * rs * gg[j]) * (1.f + sc[j]) + sh[j]; }
                u32x4 w; w.x = pk_bf16(o[0], o[1]); w.y = pk_bf16(o[2], o[3]); w.z = pk_bf16(o[4], o[5]); w.w = pk_bf16(o[6], o[7]);
                *(u32x4*)(dst + (size_t)row * 1024 + c) = w; }
        }
    }
}
__device__ void phase_final(const Params& p) {
    const int lane = threadIdx.x & 63, wid = threadIdx.x >> 6, RS = (int)gridDim.x * 8;
    for (int rowa = blockIdx.x * 8 + wid; rowa < ML; rowa += 2 * RS) {
        const bool has2 = rowa + RS < ML;
        int rows[2] = {rowa, has2 ? rowa + RS : rowa};
        f32x4 v[2][4];
#pragma unroll
        for (int u = 0; u < 2; ++u) { const float* s = p.out + (size_t)rows[u] * 1024;
            v[u][0] = *(const f32x4*)(s + 8 * lane); v[u][1] = *(const f32x4*)(s + 8 * lane + 4); v[u][2] = *(const f32x4*)(s + 512 + 8 * lane); v[u][3] = *(const f32x4*)(s + 512 + 8 * lane + 4); }
#pragma unroll
        for (int u = 0; u < 2; ++u) {
            if (u == 1 && !has2) break;
            float* s = p.out + (size_t)rows[u] * 1024;
            float ss = 0.f;
#pragma unroll
            for (int i = 0; i < 4; ++i)
#pragma unroll
                for (int j = 0; j < 4; ++j) ss += v[u][i][j] * v[u][i][j];
            ss = wave_sum(ss);
            const float rs = rsqrtf(ss * (1.f / 1024.f) + 1e-6f);
#pragma unroll
            for (int i = 0; i < 4; ++i) { const int c = (i >> 1) * 512 + 8 * lane + 4 * (i & 1); const f32x4 gg = *(const f32x4*)(p.g_final + c); *(f32x4*)(s + c) = v[u][i] * rs * gg; }
        }
    }
}

constexpr int A_DD = 0, A_QR = 8192, A_KR = 25600, A_HT = 43008, A_QD = 45056, A_KD = 79872, A_P = 114688, A_VT = 8192;
constexpr int A_RS = 272;
constexpr int A_PS = 144;
constexpr float QSCALE = 0.08838834764831845f;

template <int DIR, bool LAT>
__device__ __forceinline__ void gla_pass2(LAS unsigned char* lds, const float (&la)[32], int ch, int half, float bmid, float start, bf16_t* kdg  ) {
    float kv[32], qv[32];
#pragma unroll
    for (int i = 0; i < 32; ++i) { const int t = half * 32 + i;
        kv[i] = bf2f(*(const LAS bf16_t*)(lds + A_KR + t * A_RS + ch * 2));
        qv[i] = LAT ? bf2f(*(const LAS bf16_t*)(lds + A_QR + t * A_RS + ch * 2)) * QSCALE : 0.f; }
    float b = start; unsigned kp[16];
#pragma unroll
    for (int s = 0; s < 32; ++s) {
        const int i = DIR == 0 ? s : 31 - s; const int t = half * 32 + i;
        b += la[i];
        const float e1 = __expf(b - bmid), e2 = __builtin_amdgcn_rcpf(e1);
        const float kd = kv[i] * e2;
        const unsigned kb = pk_bf16(kd, 0.f) & 0xffffu;
        if ((i & 1) == 0) kp[i >> 1] = (DIR == 0) ? kb : (kp[i >> 1] | kb); else kp[i >> 1] = (DIR == 0) ? (kp[i >> 1] | (kb << 16)) : (kb << 16);
        if (LAT) {
            *(LAS bf16_t*)(lds + A_QD + DIR * 17408 + t * A_RS + ch * 2) = f2bf(qv[i] * e1);
            *(LAS bf16_t*)(lds + A_KD + DIR * 17408 + t * A_RS + ch * 2) = (bf16_t)kb;
        }
    }
    const int kt = ch >> 4, fr = ch & 15;
#pragma unroll
    for (int g4 = 0; g4 < 4; ++g4) { u32x4 w; w.x = kp[4 * g4]; w.y = kp[4 * g4 + 1]; w.z = kp[4 * g4 + 2]; w.w = kp[4 * g4 + 3];
        *(u32x4*)(kdg + ((kt * 2 + half) * 64 + g4 * 16 + fr) * 8) = w; }
}

__device__ void phase_gla_a(const Params& p, LAS unsigned char* lds, int vbid) {
    const int tid = threadIdx.x, lane = tid & 63, wid = tid >> 6, fr = lane & 15, fq = lane >> 4;
    const float* dd = (const float*)(p.ws + OFF_DD);
    const bf16_t* qb = (const bf16_t*)(p.ws + OFF_Q); const bf16_t* kb = (const bf16_t*)(p.ws + OFF_K);
    bf16_t* vb = (bf16_t*)(p.ws + OFF_V);
    bf16_t* Q2 = (bf16_t*)(p.ws + OFF_U); bf16_t* K2L = (bf16_t*)p.out; bf16_t* VTL = (bf16_t*)p.out + (size_t)32 * 1024 * 1024;
    bf16_t* K2C = (bf16_t*)(p.ws + OFF_WFFI); bf16_t* VTC = (bf16_t*)(p.ws + OFF_WFFI) + (size_t)2 * 1024 * 1024; float* dec = (float*)(p.ws + OFF_DEC);
#define GA_DECODE(it_, lat_, b_, c_, h_, row0_, cidx_) do { lat_ = (it_) < 2048; \
        if (lat_) { b_ = (it_) >> 8; c_ = ((it_) & 255) >> 2; h_ = (it_) & 3; row0_ = (size_t)b_ * SEQ + c_ * 64; cidx_ = c_; } \
        else { const int j_ = (it_) - 2048; b_ = j_ >> 4; c_ = (j_ & 15) >> 2; h_ = j_ & 3; row0_ = (size_t)ML + b_ * CTXL + c_ * 64; cidx_ = 64 + c_; } } while (0)
#define GA_FETCH_A(it_) do { if ((it_) < 2048 + 128) { bool l_; int b_, c_, h_, ci_; size_t r0_; GA_DECODE(it_, l_, b_, c_, h_, r0_, ci_); (void)ci_; \
        pdd = *(const f32x4*)(dd + (r0_ + (tid >> 3)) * 32 + 4 * (tid & 7)); \
        _Pragma("unroll") for (int i = 0; i < 2; ++i) { const int pc = tid + 512 * i, r = pc >> 4, cp = pc & 15; \
            pk[i] = *(const u32x4*)(kb + (r0_ + r) * 512 + h_ * 128 + 8 * cp); if (l_) pq[i] = *(const u32x4*)(qb + (r0_ + r) * 512 + h_ * 128 + 8 * cp); } } } while (0)
#define GA_FETCH_V(it_) do { if ((it_) < 2048 + 128) { bool l_; int b_, c_, h_, ci_; size_t r0_; GA_DECODE(it_, l_, b_, c_, h_, r0_, ci_); (void)ci_; (void)l_; \
        _Pragma("unroll") for (int i = 0; i < 4; ++i) pv[i] = *(const u32x4*)(vb + (r0_ + lane) * 1024 + h_ * 256 + 8 * (wid + 8 * i)); } } while (0)
    f32x4 pdd = {0.f, 0.f, 0.f, 0.f}; u32x4 pk[2], pq[2], pv[4];
    pk[0] = pk[1] = pq[0] = pq[1] = pv[0] = pv[1] = pv[2] = pv[3] = (u32x4){0u, 0u, 0u, 0u};
    const int ch = tid & 127, dir = (tid >> 7) & 1, half = tid >> 8;
    float w[16], bias = 0.f; int hw = -1;
#pragma unroll
    for (int r = 0; r < 16; ++r) w[r] = 0.f;
    GA_FETCH_A(vbid); GA_FETCH_V(vbid);
    for (int it = vbid; it < 2048 + 128; it += gridDim.x) {
        bool lat; int b, c, h; size_t row0; int cidx;
        GA_DECODE(it, lat, b, c, h, row0, cidx);
        { const int r = tid >> 3, c4 = tid & 7; *(LAS f32x4*)(lds + A_DD + r * 128 + c4 * 16) = pdd; }
#pragma unroll
        for (int i = 0; i < 2; ++i) { const int pc = tid + 512 * i, r = pc >> 4, cp = pc & 15;
            *(LAS u32x4*)(lds + A_KR + r * A_RS + cp * 16) = pk[i];
            if (lat) *(LAS u32x4*)(lds + A_QR + r * A_RS + cp * 16) = pq[i]; }
        if (h != hw) {
#pragma unroll
            for (int r = 0; r < 16; ++r) w[r] = p.w_dec_up[(size_t)(dir * 16 + r) * 512 + h * 128 + ch];
            bias = p.b_dec[dir * 512 + h * 128 + ch]; hw = h; }
        GA_FETCH_A(it + (int)gridDim.x);
        __syncthreads();
        float la[32]; float tot = 0.f;
#pragma unroll
        for (int g = 0; g < 8; ++g) {
            f32x4 d[4][4];
#pragma unroll
            for (int tt = 0; tt < 4; ++tt) { const LAS f32x4* dp = (const LAS f32x4*)(lds + A_DD + (half * 32 + 4 * g + tt) * 128 + dir * 64);
#pragma unroll
                for (int q4 = 0; q4 < 4; ++q4) d[tt][q4] = dp[q4]; }
            asm volatile("" ::: "memory");
#pragma unroll
            for (int tt = 0; tt < 4; ++tt) { f32x2_t za = {bias, 0.f}, zb = {0.f, 0.f};
#pragma unroll
                for (int q4 = 0; q4 < 4; ++q4) { const f32x2_t dlo = {d[tt][q4][0], d[tt][q4][1]}, dhi = {d[tt][q4][2], d[tt][q4][3]};
                    const f32x2_t wlo = {w[4 * q4], w[4 * q4 + 1]}, whi = {w[4 * q4 + 2], w[4 * q4 + 3]};
                    za = __builtin_elementwise_fma(dlo, wlo, za); zb = __builtin_elementwise_fma(dhi, whi, zb); }
                const f32x2_t zs = za + zb; const float z = zs[0] + zs[1];
                const float l = (fminf(z, 0.f) - 0.69314718056f * __builtin_amdgcn_logf(1.f + __expf(-fabsf(z)))) * (1.f / 16.f);
                la[4 * g + tt] = l; tot += l; } }
        ((LAS float*)(lds + A_HT))[(dir * 2 + half) * 128 + ch] = tot;
        __syncthreads();
        { const float h0 = ((LAS float*)(lds + A_HT))[(dir * 2 + 0) * 128 + ch], h1 = ((LAS float*)(lds + A_HT))[(dir * 2 + 1) * 128 + ch];
            const float blast = h0 + h1, bmid = dir == 0 ? h0 : h1;
            const size_t cbase = (((size_t)dir * 8 + b) * 4 + h) * NCH + cidx;
            const size_t gb_ = ((size_t)dir * 8 + b) * 4 + h;
            bf16_t* kdg = lat ? K2L + (gb_ * 64 + c) * 8192 : K2C + (gb_ * 4 + c) * 8192;
            if (dir == 0) { if (lat) gla_pass2<0, true>(lds, la, ch, half, bmid, half ? h0 : 0.f, kdg); else gla_pass2<0, false>(lds, la, ch, half, bmid, half ? h0 : 0.f, kdg); }
            else { if (lat) gla_pass2<1, true>(lds, la, ch, half, bmid, half ? 0.f : h1, kdg); else gla_pass2<1, false>(lds, la, ch, half, bmid, half ? 0.f : h1, kdg); }
            if (half == 0) { float* sp = dec + cbase * 384 + ch; sp[0] = __expf(blast); sp[128] = __expf(blast - bmid); ((LAS float*)(lds + A_DD))[dir * 128 + ch] = __expf(bmid); } }
        __syncthreads();
#pragma unroll
        for (int i = 0; i < 4; ++i) { const int t = lane, cp = wid + 8 * i;
            const u32x4 vv = pv[i];
#pragma unroll
            for (int e = 0; e < 4; ++e) { *(LAS bf16_t*)(lds + A_VT + (8 * cp + 2 * e) * A_PS + t * 2) = (bf16_t)(vv[e] & 0xffffu); *(LAS bf16_t*)(lds + A_VT + (8 * cp + 2 * e + 1) * A_PS + t * 2) = (bf16_t)(vv[e] >> 16); } }
        GA_FETCH_V(it + (int)gridDim.x);
        if (lat) {
            const int rt = wid >> 1, ct0 = (wid & 1) * 2;
            f32x4 ps[2] = {{0.f, 0.f, 0.f, 0.f}, {0.f, 0.f, 0.f, 0.f}};
#pragma unroll
            for (int d = 0; d < 2; ++d)
#pragma unroll
                for (int cc = 0; cc < 2; ++cc) { const int ct = ct0 + cc; f32x4 a = {0.f, 0.f, 0.f, 0.f};
#pragma unroll
                    for (int ks = 0; ks < 4; ++ks) { const bf16x8 af = *(const LAS bf16x8*)(lds + A_QD + d * 17408 + (16 * rt + fr) * A_RS + (32 * ks + 8 * fq) * 2), bfr = *(const LAS bf16x8*)(lds + A_KD + d * 17408 + (16 * ct + fr) * A_RS + (32 * ks + 8 * fq) * 2);
                        a = __builtin_amdgcn_mfma_f32_16x16x32_bf16(af, bfr, a, 0, 0, 0); }
#pragma unroll
                    for (int r = 0; r < 4; ++r) { const int i = 16 * rt + 4 * fq + r, j = 16 * ct + fr; const bool keep = d == 0 ? (i >= j) : (j >= i); ps[cc][r] += keep ? a[r] : 0.f; } }
#pragma unroll
            for (int cc = 0; cc < 2; ++cc)
#pragma unroll
                for (int r = 0; r < 4; ++r) *(LAS bf16_t*)(lds + A_P + (16 * rt + 4 * fq + r) * A_PS + (16 * (ct0 + cc) + fr) * 2) = f2bf(ps[cc][r]);
        }
        __syncthreads();
        { bf16_t* vtg = lat ? VTL + (((size_t)b * 4 + h) * 64 + c) * 16384 : VTC + (((size_t)b * 4 + h) * 4 + c) * 16384;
#pragma unroll
            for (int i = 0; i < 4; ++i) { const int pc = tid + 512 * i, vc = pc >> 3, tp = pc & 7;
                *(u32x4*)(vtg + (((vc >> 4) * 2 + (tp >> 2)) * 64 + (tp & 3) * 16 + (vc & 15)) * 8) = *(const LAS u32x4*)(lds + A_VT + vc * A_PS + tp * 16); } }
        if (lat) {
#pragma unroll
            for (int d = 0; d < 2; ++d) { bf16_t* qg = Q2 + ((((size_t)d * 8 + b) * 4 + h) * 64 + c) * 8192;
#pragma unroll
                for (int i = 0; i < 2; ++i) { const int pc = tid + 512 * i, t = pc >> 4, cp = pc & 15;
                    const u32x4 qv = *(const LAS u32x4*)(lds + A_QD + d * 17408 + t * A_RS + cp * 16);
                    const f32x4 e0 = *(const LAS f32x4*)(lds + A_DD + (d * 128 + 8 * cp) * 4), e1 = *(const LAS f32x4*)(lds + A_DD + (d * 128 + 8 * cp + 4) * 4);
                    u32x4 w; w.x = pk_bf16(bf_lo(qv.x) * e0[0], bf_hi(qv.x) * e0[1]); w.y = pk_bf16(bf_lo(qv.y) * e0[2], bf_hi(qv.y) * e0[3]);
                    w.z = pk_bf16(bf_lo(qv.z) * e1[0], bf_hi(qv.z) * e1[1]); w.w = pk_bf16(bf_lo(qv.w) * e1[2], bf_hi(qv.w) * e1[3]);
                    *(u32x4*)(qg + (((t >> 4) * 4 + (cp >> 2)) * 64 + (cp & 3) * 16 + (t & 15)) * 8) = w; } }
        }
        if (lat) {
#pragma unroll
            for (int vv = 0; vv < 2; ++vv) { const int vct = 2 * wid + vv;
#pragma unroll
                for (int rt = 0; rt < 4; ++rt) { f32x4 a = {0.f, 0.f, 0.f, 0.f};
#pragma unroll
                    for (int ks = 0; ks < 2; ++ks) { const bf16x8 af = *(const LAS bf16x8*)(lds + A_VT + (16 * vct + fr) * A_PS + (32 * ks + 8 * fq) * 2), bfr = *(const LAS bf16x8*)(lds + A_P + (16 * rt + fr) * A_PS + (32 * ks + 8 * fq) * 2);
                        a = __builtin_amdgcn_mfma_f32_16x16x32_bf16(af, bfr, a, 0, 0, 0); }
                    u32x2 w; w.x = pk_bf16(a[0], a[1]); w.y = pk_bf16(a[2], a[3]);
                    *(u32x2*)(vb + (row0 + 16 * rt + fr) * 1024 + h * 256 + 16 * vct + 4 * fq) = w; } }
        }
        __syncthreads();
    }
}

constexpr int B_SLOT = 41984;
constexpr int B_ST = 2 * B_SLOT, B_STS = 272;
__device__ void phase_gla_b(const Params& p, LAS unsigned char* lds, int vbid) {
    const int tid = threadIdx.x, lane = tid & 63, wid = __builtin_amdgcn_readfirstlane(tid >> 6), fr = lane & 15, fq = lane >> 4;
    const bf16_t* QD = (const bf16_t*)(p.ws + OFF_U); const bf16_t* K2L = (const bf16_t*)p.out; const bf16_t* VTL = (const bf16_t*)p.out + (size_t)32 * 1024 * 1024;
    const bf16_t* K2C = (const bf16_t*)(p.ws + OFF_WFFI); const bf16_t* VTC = (const bf16_t*)(p.ws + OFF_WFFI) + (size_t)2 * 1024 * 1024; const float* scal = (const float*)(p.ws + OFF_DEC);
    bf16_t* of = (bf16_t*)(p.ws + OFF_Q); bf16_t* vb = (bf16_t*)(p.ws + OFF_V);
    const int kt0 = (wid >> 1) * 2, ct0 = (wid & 1) * 2, rt = wid & 3, vct0 = (wid >> 2) * 2;
    for (int it = vbid; it < 256; it += gridDim.x) {
        const int grp = (it & 7) * 8 + ((it >> 3) >> 2), vs = (it >> 3) & 3, b = grp >> 3, h = (grp >> 1) & 3, dir = grp & 1;
        const size_t gbase = (((size_t)dir * 8 + b) * 4 + h);
        const bf16_t* k2l = K2L + gbase * 64 * 8192 + wid * 512 + lane * 8; const bf16_t* k2c = K2C + gbase * 4 * 8192 + wid * 512 + lane * 8;
        const bf16_t* vtl = VTL + (((size_t)b * 4 + h) * 64) * 16384 + (size_t)(vs * 8 + wid) * 512 + lane * 8; const bf16_t* vtc = VTC + (((size_t)b * 4 + h) * 4) * 16384 + (size_t)(vs * 8 + wid) * 512 + lane * 8;
        const bf16_t* q2b = QD + gbase * 64 * 8192 + wid * 512 + lane * 8;
        const float* dcb = scal + gbase * NCH * 384 + lane * 4;
        f32x4 S[2][2];
#pragma unroll
        for (int i = 0; i < 2; ++i)
#pragma unroll
            for (int j = 0; j < 2; ++j) S[i][j] = (f32x4){0.f, 0.f, 0.f, 0.f};
        u32x4 RA[6], RB[6]; u32x2 obA[2], obB[2];
        obA[0] = obA[1] = obB[0] = obB[1] = (u32x2){0u, 0u};
#define GB_STAGE(R, n_) do { const int nn_ = (n_) < NCH ? (n_) : NCH - 1; const int ci_ = dir == 0 ? (nn_ < 4 ? 64 + nn_ : nn_ - 4) : 67 - nn_; const int cq_ = nn_ < 4 ? 0 : (dir == 0 ? nn_ - 4 : 67 - nn_); \
            const bf16_t* kp_ = ci_ < 64 ? k2l + (size_t)ci_ * 8192 : k2c + (size_t)(ci_ - 64) * 8192; const bf16_t* vp_ = ci_ < 64 ? vtl + (size_t)ci_ * 16384 : vtc + (size_t)(ci_ - 64) * 16384; \
            R[0] = *(const u32x4*)(kp_); R[1] = *(const u32x4*)(kp_ + 8 * 512); R[2] = *(const u32x4*)(vp_); \
            R[3] = *(const u32x4*)(q2b + (size_t)cq_ * 8192); R[4] = *(const u32x4*)(q2b + (size_t)cq_ * 8192 + 8 * 512); \
            if (wid == 0) R[5] = *(const u32x4*)(dcb + (size_t)ci_ * 384); } while (0)
#define GB_OBLOAD(OB, n_) do { if (dir == 1 && (n_) >= 4 && (n_) < NCH) { const int ncl_ = 67 - (n_); \
            _Pragma("unroll") for (int jj = 0; jj < 2; ++jj) OB[jj] = *(const u32x2*)(vb + ((size_t)b * SEQ + ncl_ * 64 + 16 * rt + fr) * 1024 + h * 256 + vs * 64 + 16 * (vct0 + jj) + 4 * fq); } } while (0)
#define GB_STEP(R, OB, n) do { \
            const bool lat = (n) >= 4; const int cl = dir == 0 ? (n) - 4 : 67 - (n); \
            LAS unsigned char* slot = lds + ((n) & 1) * B_SLOT; \
            LAS unsigned char* st = lds + B_ST + ((n) & 1) * 17408; \
            *(LAS u32x4*)(slot + wid * 1024 + lane * 16) = R[0]; *(LAS u32x4*)(slot + (wid + 8) * 1024 + lane * 16) = R[1]; *(LAS u32x4*)(slot + 16384 + wid * 1024 + lane * 16) = R[2]; \
            *(LAS u32x4*)(slot + 24576 + wid * 1024 + lane * 16) = R[3]; *(LAS u32x4*)(slot + 24576 + (wid + 8) * 1024 + lane * 16) = R[4]; \
            if (wid == 0) *(LAS u32x4*)(slot + 40960 + lane * 16) = R[5]; \
            if (lat) { \
                _Pragma("unroll") for (int i = 0; i < 2; ++i) \
                    _Pragma("unroll") for (int j = 0; j < 2; ++j) { const f32x4 sv = S[i][j]; u32x2 w; w.x = pk_bf16(sv[0], sv[1]); w.y = pk_bf16(sv[2], sv[3]); \
                        *(LAS u32x2*)(st + (16 * (ct0 + j) + fr) * B_STS + (16 * (kt0 + i) + 4 * fq) * 2) = w; } } \
            GB_STAGE(R, (n) + 2); \
            __syncthreads(); \
            _Pragma("unroll") for (int i = 0; i < 2; ++i) { \
                const f32x4 dcv = *(const LAS f32x4*)(slot + 40960 + (16 * (kt0 + i) + 4 * fq) * 4), elv = *(const LAS f32x4*)(slot + 40960 + 512 + (16 * (kt0 + i) + 4 * fq) * 4); \
                _Pragma("unroll") for (int j = 0; j < 2; ++j) { f32x4 pacc = {0.f, 0.f, 0.f, 0.f}; \
                    _Pragma("unroll") for (int ks = 0; ks < 2; ++ks) { const bf16x8 kfr = *(const LAS bf16x8*)(slot + ((kt0 + i) * 2 + ks) * 1024 + lane * 16), vfr = *(const LAS bf16x8*)(slot + 16384 + ((ct0 + j) * 2 + ks) * 1024 + lane * 16); \
                        pacc = __builtin_amdgcn_mfma_f32_16x16x32_bf16(kfr, vfr, pacc, 0, 0, 0); } \
                    S[i][j] = S[i][j] * dcv + pacc * elv; } } \
            if (lat) { \
                _Pragma("unroll") for (int jj = 0; jj < 2; ++jj) { f32x4 a = {0.f, 0.f, 0.f, 0.f}; \
                    _Pragma("unroll") for (int ks = 0; ks < 4; ++ks) { const bf16x8 af = *(const LAS bf16x8*)(st + (16 * (vct0 + jj) + fr) * B_STS + (32 * ks + 8 * fq) * 2), qfr = *(const LAS bf16x8*)(slot + 24576 + (rt * 4 + ks) * 1024 + lane * 16); \
                        a = __builtin_amdgcn_mfma_f32_16x16x32_bf16(af, qfr, a, 0, 0, 0); } \
                    const size_t off = ((size_t)b * SEQ + cl * 64 + 16 * rt + fr) * 1024 + h * 256 + vs * 64 + 16 * (vct0 + jj) + 4 * fq; \
                    if (dir == 0) { u32x2 w; w.x = pk_bf16(a[0], a[1]); w.y = pk_bf16(a[2], a[3]); *(u32x2*)(of + off) = w; } \
                    else { const u32x2 o = OB[jj]; u32x2 w; w.x = pk_bf16(a[0] + bf_lo(o.x), a[1] + bf_hi(o.x)); w.y = pk_bf16(a[2] + bf_lo(o.y), a[3] + bf_hi(o.y)); *(u32x2*)(vb + off) = w; } } \
            } \
            GB_OBLOAD(OB, (n) + 2); } while (0)
        RA[5] = RB[5] = (u32x4){0u, 0u, 0u, 0u};
        GB_STAGE(RA, 0); GB_STAGE(RB, 1); GB_OBLOAD(obA, 4); GB_OBLOAD(obB, 5);
#pragma unroll 1
        for (int n = 0; n < NCH; n += 2) { GB_STEP(RA, obA, n); GB_STEP(RB, obB, n + 1); }
        __syncthreads();
#undef GB_STEP
#undef GB_OBLOAD
#undef GB_STAGE
    }
}

__device__ void phase_agla(const Params& p) {
    const int lane = threadIdx.x & 63, wid = threadIdx.x >> 6, sub = lane >> 5, l32 = lane & 31;
    const bf16_t* o1 = (const bf16_t*)(p.ws + OFF_V); const bf16_t* o2 = (const bf16_t*)(p.ws + OFF_Q); bf16_t* g = (bf16_t*)(p.ws + OFF_G);
    const f32x4 gh0 = *(const f32x4*)(p.g_head + 8 * l32), gh1 = *(const f32x4*)(p.g_head + 8 * l32 + 4);
    for (int i0 = (blockIdx.x * 8 + wid) * 8; i0 < ML * 4; i0 += gridDim.x * 64) {
        u32x4 a[4], b[4], gs[4]; size_t off[4];
#pragma unroll
        for (int st = 0; st < 4; ++st) { const int idx = i0 + 2 * st + sub; off[st] = (size_t)(idx >> 2) * 1024 + (idx & 3) * 256 + 8 * l32;
            a[st] = *(const u32x4*)(o1 + off[st]); b[st] = *(const u32x4*)(o2 + off[st]); gs[st] = *(const u32x4*)(g + off[st]); }
#pragma unroll
        for (int st = 0; st < 4; ++st) {
            float o[8];
#pragma unroll
            for (int e = 0; e < 4; ++e) { o[2 * e] = bf_lo(a[st][e]) + bf_lo(b[st][e]); o[2 * e + 1] = bf_hi(a[st][e]) + bf_hi(b[st][e]); }
            float ss = 0.f;
#pragma unroll
            for (int e = 0; e < 8; ++e) ss += o[e] * o[e];
#pragma unroll
            for (int m = 16; m > 0; m >>= 1) ss += __shfl_xor(ss, m);
            const float rs = rsqrtf(ss * (1.f / 256.f) + 1e-6f);
            float r[8];
#pragma unroll
            for (int e = 0; e < 4; ++e) { r[2 * e] = o[2 * e] * rs * (e < 2 ? gh0[2 * e] : gh1[2 * e - 4]) * bf_lo(gs[st][e]); r[2 * e + 1] = o[2 * e + 1] * rs * (e < 2 ? gh0[2 * e + 1] : gh1[2 * e - 3]) * bf_hi(gs[st][e]); }
            u32x4 w; w.x = pk_bf16(r[0], r[1]); w.y = pk_bf16(r[2], r[3]); w.z = pk_bf16(r[4], r[5]); w.w = pk_bf16(r[6], r[7]);
            *(u32x4*)(g + off[st]) = w;
        }
    }
}

__device__ void ffn_bias(const Params& p) {
    const int lane = threadIdx.x & 63, wid = threadIdx.x >> 6;
    const bf16_t* W = (const bf16_t*)(p.ws + OFF_WFFI); const float* mod = (const float*)(p.ws + OFF_MOD); float* bias2 = (float*)(p.ws + OFF_BIAS2);
    for (int n = blockIdx.x * 8 + wid; n < 2 * DFF; n += gridDim.x * 8) {
        const u32x4 w0 = *(const u32x4*)(W + (size_t)n * 1024 + 8 * lane), w1 = *(const u32x4*)(W + (size_t)n * 1024 + 512 + 8 * lane);
        float wv[16];
#pragma unroll
        for (int e = 0; e < 4; ++e) { wv[2 * e] = bf_lo(w0[e]); wv[2 * e + 1] = bf_hi(w0[e]); wv[8 + 2 * e] = bf_lo(w1[e]); wv[8 + 2 * e + 1] = bf_hi(w1[e]); }
#pragma unroll
        for (int b = 0; b < 8; ++b) { const float* sp = mod + (size_t)b * 6144 + 3072; float a = 0.f;
#pragma unroll
            for (int q = 0; q < 2; ++q) { const f32x4 s0 = *(const f32x4*)(sp + 8 * lane + 4 * q), s1 = *(const f32x4*)(sp + 512 + 8 * lane + 4 * q);
#pragma unroll
                for (int j = 0; j < 4; ++j) a += s0[j] * wv[4 * q + j] + s1[j] * wv[8 + 4 * q + j]; }
            a = wave_sum(a);
            if (lane == 0) bias2[(size_t)b * (2 * DFF) + n] = a; }
    }
}
__device__ void zero_rowss(const Params& p) {
    float* r = (float*)(p.ws + OFF_ROWSS);
    for (int i = blockIdx.x * 512 + threadIdx.x; i < ML; i += gridDim.x * 512) r[i] = 0.f;
}

__device__ __forceinline__ void run_phase(const Params& p, LAS unsigned char* lds, int ph, int vbid) {
    unsigned char* ws = p.ws; const float* mod = (const float*)(ws + OFF_MOD);
    const int G = (int)gridDim.x, c = vbid;
    switch (ph) {
    case 0: phase_prep(p, lds); break;
    case 1: norm_mod_rows(p.x, p.ctx, ML, MT, (bf16_t*)p.out, p.g_mix, mod, 0, 1024); break;
    case 2: { pg8::Gemm g{(const bf16_t*)p.out, (const bf16_t*)(ws + OFF_WIN), MT, NINP, 1024, 16}; pg8::InOrder S; S.init(G, c);
        EpiInProj E{(bf16_t*)(ws + OFF_Q), (bf16_t*)(ws + OFF_K), (bf16_t*)(ws + OFF_V), (bf16_t*)(ws + OFF_G), (bf16_t*)(ws + OFF_CB), (bf16_t*)(ws + OFF_GA), (bf16_t*)(ws + OFF_GB), (float*)(ws + OFF_DD), p.w_conv};
        pg8::gemm_phase(lds, g, S, E); } break;
    case 5: phase_gla_a(p, lds, vbid); break;
    case 6: phase_gla_b(p, lds, vbid); break;
    case 7: wconv_run(p, lds, WT_MIX_END, WT_END); zero_rowss(p); phase_agla(p); break;
    case 8: { ffn_bias(p); pg8::Gemm g{(const bf16_t*)(ws + OFF_CB), (const bf16_t*)(ws + OFF_WCONV), ML, 1024, 1024, 16}; pg8::DualOrder S; S.init(ML, 1024, G, c);
        EpiDual E{(bf16_t*)(ws + OFF_U), (const bf16_t*)(ws + OFF_GA), (const bf16_t*)(ws + OFF_GB)}; pg8::gemm_phase(lds, g, S, E); } break;
    case 9: { pg8::Gemm g{(const bf16_t*)(ws + OFF_U), (const bf16_t*)(ws + OFF_WMIX), ML, 1024, 1024, 16}; pg8::StaticOrder S; S.init(ML, 1024, G, c);
        EpiMix E{p.x, p.out, mod, p.g_ffn, (bf16_t*)(ws + OFF_G), (float*)(ws + OFF_ROWSS)}; pg8::gemm_phase(lds, g, S, E); } break;
    case 11: { pg8::Gemm g{(const bf16_t*)(ws + OFF_G), (const bf16_t*)(ws + OFF_WFFI), ML, 2 * DFF, 1024, 16}; pg8::StaticOrder S; S.init(ML, 2 * DFF, G, c);
        EpiFfnIn E{(bf16_t*)(ws + OFF_GA), (const float*)(ws + OFF_ROWSS), (const float*)(ws + OFF_BIAS2)}; pg8::gemm_phase(lds, g, S, E); } break;
    case 12: { pg8::Gemm g{(const bf16_t*)(ws + OFF_GA), (const bf16_t*)(ws + OFF_WFFO), ML, 1024, DFF, DFF / 64}; pg8::StaticOrder S; S.init(ML, 1024, G, c);
        EpiRes E{p.out, p.out, mod + 5120}; pg8::gemm_phase(lds, g, S, E); } break;
    case 13: phase_final(p); break;
    default: break;
    }
}

#if FUSED
__global__ void __launch_bounds__(512, 2) mega_fwd(Params p) {
    extern __shared__ __attribute__((aligned(16))) unsigned char shm[];
    LAS unsigned char* lds = (LAS unsigned char*)shm;
    volatile LAS unsigned* xst = (volatile LAS unsigned*)(lds + LDS_STAGE);
    if (threadIdx.x == 0) { xst[0] = 0u; xst[1] = 0u; xst[2] = 0u; xst[3] = 0u; }
    __syncthreads();
    const XcdBarrier xb = xcd_barrier_post((unsigned*)(p.ws + OFF_BAR), xst);
    if (threadIdx.x == 0) xst[2] = xb_add(&xb.bar[xb.x], 1u);
    int vbid = (int)blockIdx.x;
#define VBID_SETUP() do { if (threadIdx.x == 0) { unsigned cnt[16], tot = 0u, nx = 0u, pre = 0u, kx = 0u; bool eq = true; \
        _Pragma("unroll") for (unsigned j = 0; j < 16; ++j) { cnt[j] = xb_ld(&xb.bar[XB_XCNT(j)]); } \
        _Pragma("unroll") for (unsigned j = 0; j < 16; ++j) { if (cnt[j]) { if (j < xb.x) { pre += cnt[j]; ++kx; } ++nx; tot += cnt[j]; eq = eq && (cnt[j] == cnt[xb.x]); } } \
        const unsigned rank = xst[2]; xst[3] = (eq && tot == gridDim.x && nx == 8u) ? rank * 8u + kx : pre + rank; } \
        __syncthreads(); vbid = (int)xst[3]; if (vbid < 0 || vbid >= (int)gridDim.x) vbid = (int)blockIdx.x; } while (0)
#define GSYNC(n) do { xcd_barrier(xb); if ((n) == 0) VBID_SETUP(); } while (0)
#ifdef TPROBE
    unsigned long long tsum_sync = 0, tsum_sel = 0, t0, t1;
#define PH(n) t0 = __builtin_amdgcn_s_memrealtime(); run_phase(p, lds, n, vbid); asm volatile("" ::: "memory"); t1 = __builtin_amdgcn_s_memrealtime(); if ((TPROBE_MASK >> (n)) & 1) tsum_sel += t1 - t0; \
    GSYNC(n); asm volatile("" ::: "memory"); t0 = __builtin_amdgcn_s_memrealtime(); tsum_sync += t0 - t1;
    PH(0) PH(1) PH(2) PH(5) PH(6) PH(7) PH(8) PH(9) PH(11) PH(12)
    t0 = __builtin_amdgcn_s_memrealtime(); run_phase(p, lds, 13, vbid); t1 = __builtin_amdgcn_s_memrealtime(); if ((TPROBE_MASK >> 13) & 1) tsum_sel += t1 - t0;
    if (blockIdx.x == 0) { const unsigned long long want = 2ull * (TPROBE_SYNC ? tsum_sync : tsum_sel); const unsigned long long ts = __builtin_amdgcn_s_memrealtime();
        while (__builtin_amdgcn_s_memrealtime() - ts < want) __builtin_amdgcn_s_sleep(8); }
#undef PH
#else
#define PH(n) run_phase(p, lds, n, vbid); asm volatile("" ::: "memory"); GSYNC(n); asm volatile("" ::: "memory");
    PH(0) PH(1) PH(2) PH(5) PH(6) PH(7) PH(8) PH(9) PH(11) PH(12)
    run_phase(p, lds, 13, vbid);
#undef PH
#endif
}
#else
__global__ void __launch_bounds__(512, 2) mega_fwd(Params p, int ph) {
    extern __shared__ __attribute__((aligned(16))) unsigned char shm[];
    LAS unsigned char* lds = (LAS unsigned char*)shm;
    run_phase(p, lds, ph, (int)blockIdx.x);
}
#endif

extern "C" void kernel_launch(void* const* d_in, const int* in_sizes, int n_in, void* d_out, int out_size, void* d_ws, size_t ws_size, hipStream_t stream) {
    static int grid = 0;
    if (grid == 0) {
        if (n_in != 19 || out_size != ML * DM || ws_size < WS_NEED) { fprintf(stderr, "kernel_launch: unexpected shapes (n_in %d out %d ws %zu need %zu)\n", n_in, out_size, ws_size, (size_t)WS_NEED); grid = -1; return; }
        int dev = 0, cus = 0, per_cu = 0;
        (void)hipGetDevice(&dev); (void)hipDeviceGetAttribute(&cus, hipDeviceAttributeMultiprocessorCount, dev);
        if (hipFuncSetAttribute((const void*)mega_fwd, hipFuncAttributeMaxDynamicSharedMemorySize, LDS_BYTES) != hipSuccess) { fprintf(stderr, "hipFuncSetAttribute failed\n"); grid = -1; return; }
        if (hipOccupancyMaxActiveBlocksPerMultiprocessor(&per_cu, (const void*)mega_fwd, 512, LDS_BYTES) != hipSuccess || per_cu < 1) { fprintf(stderr, "occupancy query failed (%d)\n", per_cu); (void)hipGetLastError(); per_cu = 1; }
        if (per_cu > 1) per_cu = 1;
        grid = cus * per_cu;
    }
    if (grid < 0) return;
    Params p{};
    const float** f = (const float**)&p;
    for (int i = 0; i < 19; ++i) f[i] = (const float*)d_in[i];
    p.out = (float*)d_out; p.ws = (unsigned char*)d_ws;
#if FUSED
    (void)hipMemsetAsync((char*)d_ws + OFF_BAR, 0, BAR_BYTES, stream);
    void* args[] = {&p};
    hipError_t e = hipLaunchCooperativeKernel((const void*)mega_fwd, dim3(grid), dim3(512), args, LDS_BYTES, stream);
    if (e != hipSuccess) fprintf(stderr, "cooperative launch failed: %s (grid %d)\n", hipGetErrorString(e), grid);
#else
    for (int ph = 0; ph < NPHASE; ++ph) hipLaunchKernelGGL(mega_fwd, dim3(grid), dim3(512), LDS_BYTES, stream, p, ph);
#endif
}
```

```cpp
#include <hip/hip_runtime.h>
#include <hip/hip_cooperative_groups.h>
#include <cstdio>
namespace cg = cooperative_groups;

#ifndef FUSED
#define FUSED 1
#endif

#define LAS __attribute__((address_space(3)))
typedef unsigned short bf16_t;
typedef short bf16x8 __attribute__((ext_vector_type(8)));
typedef float f32x4 __attribute__((ext_vector_type(4)));
typedef unsigned u32x4 __attribute__((ext_vector_type(4)));
typedef unsigned u32x2 __attribute__((ext_vector_type(2)));

constexpr int DM = 1024, NB = 8, SEQ = 4096, CTXL = 256;
constexpr int ML = NB * SEQ, MC = NB * CTXL, MT = ML + MC;
constexpr int DFF = 2816, NIN = 8224, NINP = 8448, NCH = 68;
constexpr int LDS_STAGE = 131072;
constexpr int LDS_BYTES = LDS_STAGE + 16;
constexpr int NPHASE = 14;

constexpr size_t OFF_WIN = 0;
constexpr size_t OFF_WGLA = OFF_WIN + (size_t)NINP * 1024 * 2;
constexpr size_t OFF_WCONV = OFF_WGLA + 2097152;
constexpr size_t OFF_WMIX = OFF_WCONV + 2097152;
constexpr size_t OFF_WFFI = OFF_WMIX + 2097152;
constexpr size_t OFF_WFFO = OFF_WFFI + (size_t)5632 * 1024 * 2;
constexpr size_t OFF_MOD = OFF_WFFO + (size_t)1024 * 2816 * 2;
constexpr size_t OFF_DEC = OFF_MOD + (size_t)9 * 6144 * 4;
constexpr size_t OFF_DD = OFF_DEC + (size_t)2 * 8 * 4 * NCH * 384 * 4;
constexpr size_t OFF_Q = OFF_DD + (size_t)MT * 32 * 4;
constexpr size_t OFF_K = OFF_Q + (size_t)ML * 512 * 2;
constexpr size_t OFF_V = OFF_K + (size_t)MT * 512 * 2;
constexpr size_t OFF_G = OFF_V + (size_t)MT * 1024 * 2;
constexpr size_t OFF_GA = OFF_G + (size_t)ML * 1024 * 2;
constexpr size_t OFF_U = OFF_GA + (size_t)ML * 1024 * 2;
constexpr size_t OFF_CB = OFF_U + (size_t)ML * 1024 * 2;
constexpr size_t OFF_GB = OFF_CB + (size_t)ML * 1024 * 2;
constexpr size_t OFF_BAR = OFF_GB + (size_t)NB * 4 * NCH * 256 * 64 * 2;
constexpr size_t BAR_BYTES = 16384;
constexpr size_t WS_NEED = OFF_BAR + BAR_BYTES;
constexpr size_t OFF_ROWSS = OFF_DD;
constexpr size_t OFF_BIAS2 = OFF_DD + 262144;

struct Params {
    const float *x, *c, *ctx, *c_ctx, *w_ada, *b_ada, *g_mix, *w_in, *w_dec_up, *b_dec, *g_head, *w_gla_out, *w_conv, *w_conv_out,
        *w_mix_out, *g_ffn, *w_ffn_in, *w_ffn_out, *g_final;
    float* out;
    unsigned char* ws;
};

typedef __bf16 bf16v2_t __attribute__((ext_vector_type(2)));
typedef float f32x2_t __attribute__((ext_vector_type(2)));
__device__ __forceinline__ unsigned pk_bf16(float lo, float hi) { const f32x2_t v = {lo, hi}; const bf16v2_t b = __builtin_convertvector(v, bf16v2_t); return __builtin_bit_cast(unsigned, b); }
__device__ __forceinline__ float bf_lo(unsigned w) { return __uint_as_float(w << 16); }
__device__ __forceinline__ float bf_hi(unsigned w) { return __uint_as_float(w & 0xffff0000u); }
__device__ __forceinline__ float bf2f(bf16_t b) { return __uint_as_float(((unsigned)b) << 16); }
__device__ __forceinline__ bf16_t f2bf(float f) { return (bf16_t)(pk_bf16(f, 0.f) & 0xffffu); }
__device__ __forceinline__ float wave_sum(float v) {
#pragma unroll
    for (int o = 32; o > 0; o >>= 1) v += __shfl_xor(v, o);
    return v;
}
__device__ __forceinline__ float sigmoidf_(float v) { return __builtin_amdgcn_rcpf(1.f + __expf(-v)); }


#define XB_TMO      128
#define XB_XCNT(j)  (256  + 64 * (j))
#define XB_XSUB(j)  (1280 + 64 * (j))
#define XB_XGEN(j)  (2304 + 64 * (j))
#define XB_TOP      3328
#define XB_TOPGEN   3392
#define XCD_BAR_WORDS 3456
#define XB_SPIN_CAP (1u << 18)
__device__ __forceinline__ unsigned xb_ld(unsigned* p)              { return __hip_atomic_load(p, __ATOMIC_RELAXED, __HIP_MEMORY_SCOPE_AGENT); }
__device__ __forceinline__ unsigned xb_add(unsigned* p, unsigned v) { return __hip_atomic_fetch_add(p, v, __ATOMIC_RELAXED, __HIP_MEMORY_SCOPE_AGENT); }
__device__ __forceinline__ unsigned xb_xcc_id() { return (unsigned)__builtin_amdgcn_s_getreg((3 << 11) | 20) & 0xFu; }
#define XB_SPIN(cond, bar) do { unsigned _sp = 0; while (cond) { __builtin_amdgcn_s_sleep(1); \
    if ((++_sp & 255u) == 0u) { if (xb_ld(&(bar)[XB_TMO])) break; if (_sp > XB_SPIN_CAP) { atomicAdd(&(bar)[XB_TMO], 1u); break; } } } } while (0)
struct XcdBarrier { unsigned* bar; unsigned x; volatile LAS unsigned* st; };
__device__ __forceinline__ XcdBarrier xcd_barrier_post(unsigned* bar, volatile LAS unsigned* st) {
    XcdBarrier b; b.bar = bar; b.x = xb_xcc_id(); b.st = st;
    if (threadIdx.x == 0) (void)xb_add(&bar[XB_XCNT(b.x)], 1u);
    return b;
}
__device__ __forceinline__ void xcd_barrier_complete(unsigned* bar, unsigned x, unsigned& nloc, unsigned& nx) {
    const unsigned G = gridDim.x * gridDim.y * gridDim.z;
    unsigned sum, cnt, mine, sp = 0u;
    for (;;) {
        sum = 0u; cnt = 0u; mine = 0u;
#pragma unroll
        for (unsigned j = 0; j < 16; ++j) { const unsigned c = xb_ld(&bar[XB_XCNT(j)]); sum += c; cnt += (c > 0u) ? 1u : 0u; mine = (j == x) ? c : mine; }
        if (sum == G) break;
        __builtin_amdgcn_s_sleep(1);
        if ((++sp & 255u) == 0u) { if (xb_ld(&bar[XB_TMO])) break; if (sp > XB_SPIN_CAP) { atomicAdd(&bar[XB_TMO], 1u); break; } }
    }
    nloc = mine > 0u ? mine : 1u; nx = cnt > 0u ? cnt : 1u;
}
__device__ __forceinline__ void xcd_barrier(const XcdBarrier& b) {
    asm volatile("s_waitcnt vmcnt(0)" ::: "memory");
    __syncthreads();
    if (threadIdx.x == 0) {
        unsigned* bar = b.bar;
        __builtin_amdgcn_s_waitcnt(0);
        unsigned nloc = b.st[0], nx = b.st[1];
        if (nloc == 0u) { xcd_barrier_complete(bar, b.x, nloc, nx); b.st[0] = nloc; b.st[1] = nx; }
        const unsigned old = xb_add(&bar[XB_XSUB(b.x)], 1u);
        const unsigned gen = old / nloc;
        if (old + 1u == (gen + 1u) * nloc) {
            __builtin_amdgcn_fence(__ATOMIC_RELEASE, "agent");
            asm volatile("s_waitcnt vmcnt(0)" ::: "memory");
            const unsigned og = xb_add(&bar[XB_TOP], 1u);
            const unsigned tg = og / nx;
            if (og + 1u == (tg + 1u) * nx) xb_add(&bar[XB_TOPGEN], 1u);
            else XB_SPIN(xb_ld(&bar[XB_TOPGEN]) == tg, bar);
            __builtin_amdgcn_fence(__ATOMIC_ACQUIRE, "agent");
            xb_add(&bar[XB_XGEN(b.x)], 1u);
            asm volatile("s_waitcnt vmcnt(0)" ::: "memory");
        } else {
            XB_SPIN(xb_ld(&bar[XB_XGEN(b.x)]) == gen, bar);
            __builtin_amdgcn_fence(__ATOMIC_ACQUIRE, "agent");
            asm volatile("s_waitcnt vmcnt(0)" ::: "memory");
        }
    }
    __syncthreads();
}

namespace pg8 {
constexpr int BM = 256, BK = 64, HALF = 128, HTB = HALF * BK * 2, NXCD = 8, WGM = 2;
__device__ __forceinline__ int lds_byte(int r, int c) { const int st = (r >> 4) * 2 + (c >> 5), rr = r & 15, cc = c & 31, ob = rr * 64 + cc * 2; return st * 1024 + (ob ^ (((ob >> 9) & 1) << 5)); }
__device__ __forceinline__ void stage_rc(int b, int& R, int& C) { const int st = b / 1024, sb = b % 1024, swz = sb ^ (((sb >> 9) & 1) << 5); R = (st >> 1) * 16 + swz / 64; C = (st & 1) * 32 + (swz % 64) / 2; }
__device__ __forceinline__ int perm32(int rho) { const int n = rho >> 4, i = rho & 15; return 8 * (i >> 2) + 4 * n + (i & 3); }
struct Unit { int pm, pn, kind; };
struct Gemm { const bf16_t* A; const bf16_t* Bt; int M, N, K, nt; };

struct StaticOrder {
    int nM, nN, nwg, G, c;
    __device__ void init(int M, int N, int G_, int c_) { nM = M / BM; nN = N / BM; nwg = nM * nN; G = G_; c = c_; }
    __device__ bool next(int i, Unit& u) const {
        const long L = (long)i * G + c; if (L >= nwg) return false;
        int wgid = (int)L; { const int q = nwg / NXCD, r = nwg % NXCD, xcd = wgid % NXCD, off = wgid / NXCD; wgid = (xcd < r ? xcd * (q + 1) : r * (q + 1) + (xcd - r) * q) + off; }
        const int nig = WGM * nN, gid = wgid / nig, fm = gid * WGM, gsz = (nM - fm) < WGM ? (nM - fm) : WGM;
        u.pm = fm + ((wgid % nig) % gsz); u.pn = (wgid % nig) / gsz; u.kind = 0; return true;
    }
};
struct DualOrder {
    StaticOrder so;
    __device__ void init(int M, int N, int G_, int c_) { so.init(M, N, G_, c_); }
    __device__ bool next(int i, Unit& u) const { if (!so.next(i >> 1, u)) return false; u.kind = i & 1; return true; }
};
struct InOrder {
    StaticOrder so;
    __device__ void init(int G_, int c_) { so.init(ML, NINP, G_, c_); }
    __device__ bool next(int i, Unit& u) const {
        const long L = (long)i * so.G + so.c;
        if (L < so.nwg) return so.next(i, u);
        const int j = (int)(L - so.nwg); if (j >= 56) return false;
        u.pm = 128 + j / 7; const int cc = j % 7; u.pn = cc < 2 ? 2 + cc : (cc < 6 ? 4 + (cc - 2) : 32); u.kind = 0; return true;
    }
};

template <class Epi, class Sched>
__device__ __forceinline__ void gemm_phase(LAS unsigned char* lds, const Gemm g, const Sched& S, const Epi& E) {
    const int tid = threadIdx.x, wid = __builtin_amdgcn_readfirstlane(tid >> 6), lane = tid & 63, wr = wid >> 2, wc = wid & 3, fr = lane & 15, fq = lane >> 4;
    const int K = g.K, nt = g.nt;
    unsigned voffA[2], voffB[2];
#pragma unroll
    for (int i = 0; i < 2; ++i) { int R, C; stage_rc(tid * 16 + i * 8192, R, C); const int Rb = Epi::PERM ? ((R & ~31) + perm32(R & 31)) : R;
        voffA[i] = (unsigned)(R * K + C) * 2u; voffB[i] = (unsigned)(Rb * K + C) * 2u; }
    const size_t kstep = (size_t)(BK * 2);
    const size_t hstep = (size_t)HALF * K * 2;
    const size_t tstep = 2 * hstep;
    const unsigned ldsw = (unsigned)wid * 1024u;
    const int aoff = lds_byte(wr * 64 + fr, fq * 8), boff = lds_byte(wc * 32 + fr, fq * 8);
#define PG8_SA(b, h) (((b) * 2 + (h)) * HTB)
#define PG8_SB(b, h) ((4 + (b) * 2 + (h)) * HTB)
#define PG8_STAGE(bufoff, gbase, voff) do { _Pragma("unroll") for (int _i = 0; _i < 2; ++_i) \
        __builtin_amdgcn_global_load_lds((const unsigned*)((const char*)(gbase) + (voff)[_i]), (LAS unsigned*)(lds + (bufoff) + ldsw + _i * 8192), 16, 0, 0); } while (0)
#define PG8_LDA(dst, b, h) do { _Pragma("unroll") for (int m = 0; m < 4; ++m) _Pragma("unroll") for (int k = 0; k < 2; ++k) dst[m][k] = *(const LAS bf16x8*)(lds + PG8_SA(b, h) + aoff + m * 2048 + k * 1024); } while (0)
#define PG8_LDB(dst, b, h) do { _Pragma("unroll") for (int n = 0; n < 2; ++n) _Pragma("unroll") for (int k = 0; k < 2; ++k) dst[n][k] = *(const LAS bf16x8*)(lds + PG8_SB(b, h) + boff + n * 2048 + k * 1024); } while (0)
#define PG8_MMA(ai, bj, At, Bt) do { __builtin_amdgcn_s_setprio(1); _Pragma("unroll") for (int m = 0; m < 4; ++m) _Pragma("unroll") for (int n = 0; n < 2; ++n) _Pragma("unroll") for (int k = 0; k < 2; ++k) \
        acc[ai][bj][m][n] = __builtin_amdgcn_mfma_f32_16x16x32_bf16(Bt[n][k], At[m][k], acc[ai][bj][m][n], 0, 0, 0); __builtin_amdgcn_s_setprio(0); } while (0)
#define PG8_WAIT_V(n) asm volatile("s_waitcnt vmcnt(" #n ")" ::: "memory")
#define PG8_WAIT_L(n) asm volatile("s_waitcnt lgkmcnt(" #n ")" ::: "memory")
#define PG8_BAR __builtin_amdgcn_s_barrier()
#define PG8_SCHED __builtin_amdgcn_sched_barrier(0)
    Unit cur, nxt; int ui = 0;
    if (!S.next(0, cur)) return;
    f32x4 acc[2][2][4][2];
#pragma unroll
    for (int a = 0; a < 2; ++a)
#pragma unroll
        for (int b = 0; b < 2; ++b)
#pragma unroll
            for (int m = 0; m < 4; ++m)
#pragma unroll
                for (int n = 0; n < 2; ++n) acc[a][b][m][n] = (f32x4){0.f, 0.f, 0.f, 0.f};
    bf16x8 At[4][2], B0[2][2], B1[2][2];
#define PG8_UA(u) ((const char*)g.A + (size_t)(u).pm * tstep + ((Epi::DUAL && (u).kind) ? Epi::DA2 : 0l))
#define PG8_UB(u) ((const char*)g.Bt + (size_t)(u).pn * tstep + ((Epi::DUAL && (u).kind) ? Epi::DB2 : 0l))
    const char* cA = PG8_UA(cur); const char* cB = PG8_UB(cur);
    PG8_STAGE(PG8_SB(0, 0), cB, voffB); PG8_STAGE(PG8_SA(0, 0), cA, voffA); PG8_STAGE(PG8_SB(0, 1), cB + hstep, voffB); PG8_STAGE(PG8_SA(0, 1), cA + hstep, voffA);
    if (wr == 1) PG8_BAR;
    PG8_WAIT_V(4); PG8_BAR;
    PG8_STAGE(PG8_SB(1, 0), cB + kstep, voffB); PG8_STAGE(PG8_SA(1, 0), cA + kstep, voffA); PG8_STAGE(PG8_SB(1, 1), cB + hstep + kstep, voffB);
    PG8_WAIT_V(6); PG8_BAR;
    for (;;) {
        const bool has_next = S.next(ui + 1, nxt);
        const char* nA = has_next ? PG8_UA(nxt) : cA; const char* nB = has_next ? PG8_UB(nxt) : cB;
#define PG8_ITER(t) do { \
            const bool last = (t == nt - 2); \
            const char* a1 = cA + (size_t)(t + 1) * kstep; \
            const char* a2 = last ? nA : cA + (size_t)(t + 2) * kstep; \
            const char* b2 = last ? nB : cB + (size_t)(t + 2) * kstep; \
            const char* a3 = a2 + kstep; const char* b3 = b2 + kstep; \
            PG8_LDB(B0, 0, 0); PG8_SCHED; PG8_LDA(At, 0, 0); PG8_STAGE(PG8_SA(1, 1), a1 + hstep, voffA); \
            PG8_WAIT_L(8); PG8_BAR; PG8_WAIT_L(0); PG8_MMA(0, 0, At, B0); PG8_BAR; PG8_SCHED; \
            PG8_LDB(B1, 0, 1); PG8_STAGE(PG8_SB(0, 0), b2, voffB); \
            PG8_BAR; PG8_WAIT_L(0); PG8_MMA(0, 1, At, B1); PG8_BAR; \
            PG8_LDA(At, 0, 1); PG8_STAGE(PG8_SA(0, 0), a2, voffA); \
            PG8_BAR; PG8_WAIT_L(0); PG8_MMA(1, 0, At, B0); PG8_BAR; PG8_SCHED; \
            PG8_STAGE(PG8_SB(0, 1), b2 + hstep, voffB); \
            PG8_WAIT_V(6); PG8_BAR; PG8_MMA(1, 1, At, B1); PG8_BAR; \
            PG8_LDB(B0, 1, 0); PG8_SCHED; PG8_LDA(At, 1, 0); PG8_STAGE(PG8_SA(0, 1), a2 + hstep, voffA); \
            PG8_WAIT_L(8); PG8_BAR; PG8_WAIT_L(0); PG8_MMA(0, 0, At, B0); PG8_BAR; PG8_SCHED; \
            PG8_LDB(B1, 1, 1); PG8_STAGE(PG8_SB(1, 0), b3, voffB); \
            PG8_BAR; PG8_WAIT_L(0); PG8_MMA(0, 1, At, B1); PG8_BAR; \
            PG8_LDA(At, 1, 1); PG8_STAGE(PG8_SA(1, 0), a3, voffA); \
            PG8_BAR; PG8_WAIT_L(0); PG8_MMA(1, 0, At, B0); PG8_BAR; PG8_SCHED; \
            PG8_STAGE(PG8_SB(1, 1), b3 + hstep, voffB); \
            PG8_WAIT_V(6); PG8_BAR; PG8_MMA(1, 1, At, B1); PG8_BAR; \
        } while (0)
        for (int t = 0; t < nt; t += 2) PG8_ITER(t);
#undef PG8_ITER
        bool keep = false;
        if constexpr (Epi::DUAL) keep = E(acc, cur, wr, wc, fr, fq); else E(acc, cur, wr, wc, fr, fq);
        if (!has_next) break;
        if (!keep) {
#pragma unroll
            for (int a = 0; a < 2; ++a)
#pragma unroll
                for (int b = 0; b < 2; ++b)
#pragma unroll
                    for (int m = 0; m < 4; ++m)
#pragma unroll
                        for (int n = 0; n < 2; ++n) acc[a][b][m][n] = (f32x4){0.f, 0.f, 0.f, 0.f};
        }
        cur = nxt; cA = nA; cB = nB; ++ui;
    }
    PG8_WAIT_V(0);
    if (wr == 0) PG8_BAR;
    PG8_BAR;
#undef PG8_UA
#undef PG8_UB
#undef PG8_SA
#undef PG8_SB
#undef PG8_STAGE
#undef PG8_LDA
#undef PG8_LDB
#undef PG8_MMA
#undef PG8_WAIT_V
#undef PG8_WAIT_L
#undef PG8_BAR
#undef PG8_SCHED
}
}
using pg8::Unit;

template <int CTRL> __device__ __forceinline__ float dpp_row(float v) { return __builtin_bit_cast(float, __builtin_amdgcn_update_dpp(0, __builtin_bit_cast(int, v), CTRL, 0xF, 0xF, false)); }
struct EpiInProj {
    static constexpr bool PERM = true, DUAL = false; static constexpr int NT1 = 0; static constexpr long DA2 = 0, DB2 = 0;
    bf16_t *q, *k, *v, *g, *aconv, *ga, *gb; float* dd; const float* wconv;
    __device__ __forceinline__ void operator()(const f32x4 (&acc)[2][2][4][2], const Unit& un, int wr, int wc, int fr, int fq) const {
        const int pn = un.pn; const size_t row0 = (size_t)un.pm * 256 + wr * 64 + fr;
        if (pn < 12 || (pn >= 28 && pn < 32)) {
            bf16_t* base; int ldc, colt, act;
            if (pn < 2) { base = q; ldc = 512; colt = pn * 256; act = 0; }
            else if (pn < 4) { base = k; ldc = 512; colt = (pn - 2) * 256; act = 0; }
            else if (pn < 8) { base = v; ldc = 1024; colt = (pn - 4) * 256; act = 0; }
            else if (pn < 12) { base = g; ldc = 1024; colt = (pn - 8) * 256; act = 1; }
            else { base = ga; ldc = 1024; colt = (pn - 28) * 256; act = 2; }
            const int col0 = colt + wc * 32 + 8 * fq;
#pragma unroll
            for (int ai = 0; ai < 2; ++ai)
#pragma unroll
                for (int m = 0; m < 4; ++m) { bf16_t* rowp = base + (row0 + ai * 128 + m * 16) * ldc + col0;
#pragma unroll
                    for (int bj = 0; bj < 2; ++bj) { f32x4 v0 = acc[ai][bj][m][0], v1 = acc[ai][bj][m][1];
                        if (act) {
#pragma unroll
                            for (int j = 0; j < 4; ++j) { const float s0 = sigmoidf_(v0[j]), s1 = sigmoidf_(v1[j]); v0[j] = act == 1 ? v0[j] * s0 : s0; v1[j] = act == 1 ? v1[j] * s1 : s1; } }
                        u32x4 w; w.x = pk_bf16(v0[0], v0[1]); w.y = pk_bf16(v0[2], v0[3]); w.z = pk_bf16(v1[0], v1[1]); w.w = pk_bf16(v1[2], v1[3]);
                        *(u32x4*)(rowp + bj * 128) = w; } }
        } else if (pn < 28) {
            const int chb = 64 * (pn - 12) + 16 * wc + 4 * fq;
            const f32x4 w0 = *(const f32x4*)(wconv + chb), w1 = *(const f32x4*)(wconv + 1024 + chb), w2 = *(const f32x4*)(wconv + 2048 + chb);
            const f32x4 zero = {0.f, 0.f, 0.f, 0.f};
#pragma unroll
            for (int ai = 0; ai < 2; ++ai) {
                f32x4 u[4], A[4], C[4];
#pragma unroll
                for (int m = 0; m < 4; ++m) { u[m] = acc[ai][0][m][1] * acc[ai][1][m][0];
#pragma unroll
                    for (int j = 0; j < 4; ++j) { A[m][j] = dpp_row<0x121>(u[m][j]); C[m][j] = dpp_row<0x12F>(u[m][j]); } }
#pragma unroll
                for (int m = 0; m < 4; ++m) {
                    const f32x4 prev = fr > 0 ? A[m] : (m > 0 ? A[m > 0 ? m - 1 : 0] : zero), next = fr < 15 ? C[m] : (m < 3 ? C[m < 3 ? m + 1 : 3] : zero);
                    const f32x4 uc = w0 * prev + w1 * u[m] + w2 * next, ac = acc[ai][0][m][0] * uc, gv = acc[ai][1][m][1];
                    const size_t off = (row0 + ai * 128 + m * 16) * 1024 + chb;
                    u32x2 wa; wa.x = pk_bf16(ac[0], ac[1]); wa.y = pk_bf16(ac[2], ac[3]); *(u32x2*)(aconv + off) = wa;
                    u32x2 wg; wg.x = pk_bf16(sigmoidf_(gv[0]), sigmoidf_(gv[1])); wg.y = pk_bf16(sigmoidf_(gv[2]), sigmoidf_(gv[3])); *(u32x2*)(gb + off) = wg;
                }
            }
        } else {
            if (wc == 0) {
#pragma unroll
                for (int ai = 0; ai < 2; ++ai)
#pragma unroll
                    for (int m = 0; m < 4; ++m) { float* rp = dd + (row0 + ai * 128 + m * 16) * 32 + 8 * fq;
                        *(f32x4*)rp = acc[ai][0][m][0]; *(f32x4*)(rp + 4) = acc[ai][0][m][1]; }
            }
        }
    }
};
template <int MODE> struct EpiGate {
    static constexpr bool PERM = true, DUAL = false; static constexpr int NT1 = 0; static constexpr long DA2 = 0, DB2 = 0;
    bf16_t* T; const bf16_t* sg;
    __device__ __forceinline__ void operator()(const f32x4 (&acc)[2][2][4][2], const Unit& un, int wr, int wc, int fr, int fq) const {
        const size_t row0 = (size_t)un.pm * 256 + wr * 64 + fr; const int col0 = un.pn * 256 + wc * 32 + 8 * fq;
#pragma unroll
        for (int ai = 0; ai < 2; ++ai)
#pragma unroll
            for (int m = 0; m < 4; ++m)
#pragma unroll
                for (int bj = 0; bj < 2; ++bj) { const size_t off = (row0 + ai * 128 + m * 16) * 1024 + col0 + bj * 128;
                    const u32x4 s = *(const u32x4*)(sg + off); const f32x4 a0 = acc[ai][bj][m][0], a1 = acc[ai][bj][m][1];
                    float o[8] = {a0[0] * bf_lo(s.x), a0[1] * bf_hi(s.x), a0[2] * bf_lo(s.y), a0[3] * bf_hi(s.y), a1[0] * bf_lo(s.z), a1[1] * bf_hi(s.z), a1[2] * bf_lo(s.w), a1[3] * bf_hi(s.w)};
                    if (MODE == 1) { const u32x4 t = *(const u32x4*)(T + off);
                        o[0] += bf_lo(t.x); o[1] += bf_hi(t.x); o[2] += bf_lo(t.y); o[3] += bf_hi(t.y); o[4] += bf_lo(t.z); o[5] += bf_hi(t.z); o[6] += bf_lo(t.w); o[7] += bf_hi(t.w); }
                    u32x4 w; w.x = pk_bf16(o[0], o[1]); w.y = pk_bf16(o[2], o[3]); w.z = pk_bf16(o[4], o[5]); w.w = pk_bf16(o[6], o[7]);
                    *(u32x4*)(T + off) = w; }
    }
};
struct EpiDual {
    static constexpr bool PERM = true, DUAL = true; static constexpr int NT1 = 16;
    static constexpr long DA2 = (long)OFF_G - (long)OFF_CB, DB2 = (long)OFF_WGLA - (long)OFF_WCONV;
    bf16_t* T; const bf16_t* sga; const bf16_t* sgb;
    __device__ __forceinline__ bool operator()(f32x4 (&acc)[2][2][4][2], const Unit& un, int wr, int wc, int fr, int fq) const {
        const unsigned lo = (unsigned)(fr * 2048 + fq * 16);
        const size_t ub = ((size_t)un.pm * 256 + wr * 64) * 2048 + ((size_t)un.pn * 256 + wc * 32) * 2;
        const char* pa = (const char*)sga + ub;
        if (un.kind == 0) {
            const char* pb = (const char*)sgb + ub;
#pragma unroll
            for (int ai = 0; ai < 2; ++ai)
#pragma unroll
                for (int mh = 0; mh < 2; ++mh) {
                    u32x4 a[2][2], b[2][2];
#pragma unroll
                    for (int mm = 0; mm < 2; ++mm)
#pragma unroll
                        for (int bj = 0; bj < 2; ++bj) { const int cb_ = (ai * 128 + (2 * mh + mm) * 16) * 2048 + bj * 256; a[mm][bj] = *(const u32x4*)(pa + cb_ + lo); b[mm][bj] = *(const u32x4*)(pb + cb_ + lo); }
#pragma unroll
                    for (int mm = 0; mm < 2; ++mm)
#pragma unroll
                        for (int bj = 0; bj < 2; ++bj) { const int m = 2 * mh + mm;
#pragma unroll
                            for (int e = 0; e < 4; ++e) { const float r0 = bf_lo(b[mm][bj][e]) * __builtin_amdgcn_rcpf(fmaxf(bf_lo(a[mm][bj][e]), 1e-30f)), r1 = bf_hi(b[mm][bj][e]) * __builtin_amdgcn_rcpf(fmaxf(bf_hi(a[mm][bj][e]), 1e-30f));
                                acc[ai][bj][m][e >> 1][2 * (e & 1)] *= r0; acc[ai][bj][m][e >> 1][2 * (e & 1) + 1] *= r1; } }
                    asm volatile("" ::: "memory");
                }
            return true;
        }
        char* pt = (char*)T + ub;
#pragma unroll
        for (int ai = 0; ai < 2; ++ai)
#pragma unroll
            for (int m = 0; m < 4; ++m)
#pragma unroll
                for (int bj = 0; bj < 2; ++bj) { const int cb_ = (ai * 128 + m * 16) * 2048 + bj * 256;
                    const u32x4 s = *(const u32x4*)(pa + cb_ + lo); const f32x4 a0 = acc[ai][bj][m][0], a1 = acc[ai][bj][m][1];
                    u32x4 w; w.x = pk_bf16(a0[0] * bf_lo(s.x), a0[1] * bf_hi(s.x)); w.y = pk_bf16(a0[2] * bf_lo(s.y), a0[3] * bf_hi(s.y));
                    w.z = pk_bf16(a1[0] * bf_lo(s.z), a1[1] * bf_hi(s.z)); w.w = pk_bf16(a1[2] * bf_lo(s.w), a1[3] * bf_hi(s.w));
                    *(u32x4*)(pt + cb_ + lo) = w; }
        return false;
    }
};
struct EpiRes {
    static constexpr bool PERM = true, DUAL = false; static constexpr int NT1 = 0; static constexpr long DA2 = 0, DB2 = 0;
    const float* xin; float* out; const float* gate;
    __device__ __forceinline__ void operator()(const f32x4 (&acc)[2][2][4][2], const Unit& un, int wr, int wc, int fr, int fq) const {
        const size_t row0 = (size_t)un.pm * 256 + wr * 64 + fr; const int col0 = un.pn * 256 + wc * 32 + 8 * fq;
        const float* gp = gate + (size_t)(un.pm >> 4) * 6144 + col0;
        f32x4 gv[2][2];
#pragma unroll
        for (int bj = 0; bj < 2; ++bj)
#pragma unroll
            for (int n = 0; n < 2; ++n) gv[bj][n] = *(const f32x4*)(gp + bj * 128 + 4 * n);
#pragma unroll
        for (int ai = 0; ai < 2; ++ai)
#pragma unroll
            for (int m = 0; m < 4; ++m)
#pragma unroll
                for (int bj = 0; bj < 2; ++bj)
#pragma unroll
                    for (int n = 0; n < 2; ++n) { const size_t off = (row0 + ai * 128 + m * 16) * 1024 + col0 + bj * 128 + 4 * n;
                        const f32x4 xv = *(const f32x4*)(xin + off); *(f32x4*)(out + off) = xv + gv[bj][n] * acc[ai][bj][m][n]; }
    }
};
struct EpiMix {
    static constexpr bool PERM = true, DUAL = false; static constexpr int NT1 = 0; static constexpr long DA2 = 0, DB2 = 0;
    const float* xin; float* out; const float* mod; const float* gffn; bf16_t* A2; float* rowss;
    __device__ __forceinline__ void operator()(const f32x4 (&acc)[2][2][4][2], const Unit& un, int wr, int wc, int fr, int fq) const {
        const size_t row0 = (size_t)un.pm * 256 + wr * 64 + fr; const int col0 = un.pn * 256 + wc * 32 + 8 * fq;
        const float* mp = mod + (size_t)(un.pm >> 4) * 6144 + col0;
        f32x4 gv[2][2], gam[2][2];
#pragma unroll
        for (int bj = 0; bj < 2; ++bj)
#pragma unroll
            for (int n = 0; n < 2; ++n) { gv[bj][n] = *(const f32x4*)(mp + 2048 + bj * 128 + 4 * n);
                gam[bj][n] = *(const f32x4*)(gffn + col0 + bj * 128 + 4 * n) * (*(const f32x4*)(mp + 4096 + bj * 128 + 4 * n) + 1.f); }
#pragma unroll
        for (int ai = 0; ai < 2; ++ai)
#pragma unroll
            for (int m = 0; m < 4; ++m) { const size_t rowb = (row0 + ai * 128 + m * 16) * 1024 + col0; float ss = 0.f;
#pragma unroll
                for (int bj = 0; bj < 2; ++bj) { f32x4 o[2];
#pragma unroll
                    for (int n = 0; n < 2; ++n) { const size_t off = rowb + bj * 128 + 4 * n; o[n] = *(const f32x4*)(xin + off) + gv[bj][n] * acc[ai][bj][m][n]; *(f32x4*)(out + off) = o[n];
#pragma unroll
                        for (int j = 0; j < 4; ++j) ss += o[n][j] * o[n][j]; }
                    const f32x4 a0 = o[0] * gam[bj][0], a1 = o[1] * gam[bj][1];
                    u32x4 w; w.x = pk_bf16(a0[0], a0[1]); w.y = pk_bf16(a0[2], a0[3]); w.z = pk_bf16(a1[0], a1[1]); w.w = pk_bf16(a1[2], a1[3]);
                    *(u32x4*)(A2 + rowb + bj * 128) = w; }
                ss += __shfl_xor(ss, 16); ss += __shfl_xor(ss, 32);
                if (fq == 0) (void)__hip_atomic_fetch_add(rowss + (row0 + ai * 128 + m * 16), ss, __ATOMIC_RELAXED, __HIP_MEMORY_SCOPE_AGENT); }
    }
};
struct EpiFfnIn {
    static constexpr bool PERM = true, DUAL = false; static constexpr int NT1 = 0; static constexpr long DA2 = 0, DB2 = 0;
    bf16_t* s; const float* rowss; const float* bias2;
    __device__ __forceinline__ void operator()(const f32x4 (&acc)[2][2][4][2], const Unit& un, int wr, int wc, int fr, int fq) const {
        const size_t row0 = (size_t)un.pm * 256 + wr * 64 + fr; const int col0 = un.pn * 128 + wc * 32 + 8 * fq;
        const float* bp = bias2 + (size_t)(un.pm >> 4) * (2 * DFF) + un.pn * 256 + wc * 32 + 8 * fq;
        f32x4 ba[2], bb[2]; float rs[2][4];
#pragma unroll
        for (int n = 0; n < 2; ++n) { ba[n] = *(const f32x4*)(bp + 4 * n); bb[n] = *(const f32x4*)(bp + 128 + 4 * n); }
#pragma unroll
        for (int ai = 0; ai < 2; ++ai)
#pragma unroll
            for (int m = 0; m < 4; ++m) rs[ai][m] = rsqrtf(rowss[row0 + ai * 128 + m * 16] * (1.f / 1024.f) + 1e-6f);
#pragma unroll
        for (int ai = 0; ai < 2; ++ai)
#pragma unroll
            for (int m = 0; m < 4; ++m) { float o[8];
#pragma unroll
                for (int n = 0; n < 2; ++n)
#pragma unroll
                    for (int j = 0; j < 4; ++j) { const float a = rs[ai][m] * acc[ai][0][m][n][j] + ba[n][j], b = rs[ai][m] * acc[ai][1][m][n][j] + bb[n][j]; o[4 * n + j] = a * sigmoidf_(a) * b; }
                u32x4 w; w.x = pk_bf16(o[0], o[1]); w.y = pk_bf16(o[2], o[3]); w.z = pk_bf16(o[4], o[5]); w.w = pk_bf16(o[6], o[7]);
                *(u32x4*)(s + (row0 + ai * 128 + m * 16) * DFF + col0) = w; }
    }
};

__device__ __forceinline__ void adaln_item(const Params& p, LAS unsigned char* lds, int it) {
    const int tid = threadIdx.x, lane = tid & 63, wid = tid >> 6;
    LAS float* sl = (LAS float*)lds;
    LAS float* red = sl + 9 * 1024;
    for (int i = tid; i < 9 * 1024; i += 512) { const int r = i >> 10, k = i & 1023; const float cv = r < 8 ? p.c[r * 1024 + k] : p.c_ctx[k]; sl[i] = cv / (1.f + __expf(-cv)); }
    __syncthreads();
    const int c0 = 32 * it, kg = tid >> 3, cq = tid & 7;
    float acc[9][4];
#pragma unroll
    for (int r = 0; r < 9; ++r)
#pragma unroll
        for (int j = 0; j < 4; ++j) acc[r][j] = 0.f;
    f32x4 wk[16];
#pragma unroll
    for (int kk = 0; kk < 16; ++kk) wk[kk] = *(const f32x4*)(p.w_ada + (size_t)(kg * 16 + kk) * 6144 + c0 + 4 * cq);
#pragma unroll
    for (int kk = 0; kk < 16; ++kk) { const int k = kg * 16 + kk;
#pragma unroll
        for (int r = 0; r < 9; ++r) { const float s = sl[r * 1024 + k];
#pragma unroll
            for (int j = 0; j < 4; ++j) acc[r][j] += s * wk[kk][j]; } }
#pragma unroll
    for (int r = 0; r < 9; ++r)
#pragma unroll
        for (int j = 0; j < 4; ++j) { float v = acc[r][j]; v += __shfl_xor(v, 8); v += __shfl_xor(v, 16); v += __shfl_xor(v, 32); acc[r][j] = v; }
    if ((lane >> 3) == 0) {
#pragma unroll
        for (int r = 0; r < 9; ++r)
#pragma unroll
            for (int j = 0; j < 4; ++j) red[(wid * 9 + r) * 32 + 4 * cq + j] = acc[r][j]; }
    __syncthreads();
    if (tid < 288) { const int r = tid >> 5, cc = tid & 31; float s = 0.f;
#pragma unroll
        for (int w = 0; w < 8; ++w) s += red[(w * 9 + r) * 32 + cc];
        ((float*)(p.ws + OFF_MOD))[r * 6144 + c0 + cc] = s + p.b_ada[c0 + cc]; }
}
struct WTile { const float* src; bf16_t* dst; int sld, dld, n0, k0, srccol, nvalid, mode; };
__device__ __forceinline__ int win_src(int R) {
    const int pn = R >> 8, c = R & 255;
    if (pn < 12) return R;
    if (pn < 28) { const int T = pn - 12, bj = c >> 7, wc = (c >> 5) & 3, fq = (c >> 3) & 3, n = (c >> 2) & 1, j = c & 3, ch64 = 16 * wc + 4 * fq + j;
        const int base = bj == 0 ? (n == 0 ? 3104 : 4128) : (n == 0 ? 5152 : 7200); return base + 64 * T + ch64; }
    if (pn < 32) return 6176 + (R - 28 * 256);
    return c < 32 ? 3072 + c : -1;
}
__device__ __forceinline__ WTile wconv_decode(const Params& p, int j) {
    WTile t; int nt, kt; t.nvalid = 64; t.mode = 0;
    if (j < 2112) { nt = j >> 4; kt = j & 15; t.src = p.w_in; t.sld = NIN; t.dst = (bf16_t*)(p.ws + OFF_WIN); t.dld = 1024; t.srccol = 0; t.mode = 1;
    } else if (j < 2880) { const int jj = j - 2112, mi = jj >> 8, r = jj & 255; nt = r >> 4; kt = r & 15; t.sld = 1024; t.dld = 1024; t.srccol = nt * 64;
        t.src = mi == 0 ? p.w_gla_out : (mi == 1 ? p.w_conv_out : p.w_mix_out); t.dst = (bf16_t*)(p.ws + (mi == 0 ? OFF_WGLA : (mi == 1 ? OFF_WCONV : OFF_WMIX)));
    } else if (j < 4288) { const int jj = j - 2880; nt = jj >> 4; kt = jj & 15; t.src = p.w_ffn_in; t.sld = 2 * DFF; t.dst = (bf16_t*)(p.ws + OFF_WFFI); t.dld = 1024;
        const int n0 = nt * 64, pt = n0 >> 8, w = n0 & 255; t.srccol = w < 128 ? 128 * pt + w : DFF + 128 * pt + (w - 128);
    } else { const int jj = j - 4288; nt = jj / 44; kt = jj % 44; t.src = p.w_ffn_out; t.sld = 1024; t.dst = (bf16_t*)(p.ws + OFF_WFFO); t.dld = DFF; t.srccol = nt * 64; }
    t.n0 = nt * 64; t.k0 = kt * 64; return t;
}
__device__ __forceinline__ void wconv_load(const WTile& t, f32x4 (&r)[2]) {
    const int tid = threadIdx.x, n4 = (tid & 15) * 4;
    const int sc = t.mode ? win_src(t.n0 + n4) : (n4 < t.nvalid ? t.srccol + n4 : -1);
#pragma unroll
    for (int i = 0; i < 2; ++i) { const int kk = (tid >> 4) + 32 * i; r[i] = sc >= 0 ? *(const f32x4*)(t.src + (size_t)(t.k0 + kk) * t.sld + sc) : (f32x4){0.f, 0.f, 0.f, 0.f}; }
}
__device__ void wconv_run(const Params& p, LAS unsigned char* lds, int jbeg, int jend) {
    const int tid = threadIdx.x;
    LAS float* tile = (LAS float*)lds;
    int j = jbeg + (int)blockIdx.x; if (j >= jend) return;
    WTile cur = wconv_decode(p, j); f32x4 r[2]; wconv_load(cur, r);
    for (;;) {
        const int jn = j + (int)gridDim.x; const bool more = jn < jend;
        { const int n4 = (tid & 15) * 4;
#pragma unroll
            for (int i = 0; i < 2; ++i) { const int kk = (tid >> 4) + 32 * i;
#pragma unroll
                for (int e = 0; e < 4; ++e) tile[kk * 65 + n4 + e] = r[i][e]; } }
        WTile nxt = cur; if (more) { nxt = wconv_decode(p, jn); wconv_load(nxt, r); }
        __syncthreads();
        { const int jr = tid >> 3, kg = tid & 7; float v[8];
#pragma unroll
            for (int e = 0; e < 8; ++e) v[e] = tile[(8 * kg + e) * 65 + jr];
            u32x4 w; w.x = pk_bf16(v[0], v[1]); w.y = pk_bf16(v[2], v[3]); w.z = pk_bf16(v[4], v[5]); w.w = pk_bf16(v[6], v[7]);
            *(u32x4*)(cur.dst + (size_t)(cur.n0 + jr) * cur.dld + cur.k0 + 8 * kg) = w; }
        __syncthreads();
        if (!more) break;
        cur = nxt; j = jn;
    }
}
constexpr int WT_MIX_END = 2112 + 768, WT_END = 2112 + 768 + 1408 + 704;
__device__ void phase_prep(const Params& p, LAS unsigned char* lds) {
    if (blockIdx.x < 192) { adaln_item(p, lds, blockIdx.x); __syncthreads(); }
    wconv_run(p, lds, 0, WT_MIX_END);
}

__device__ __forceinline__ void norm_mod_rows(const float* src0, const float* src1, int nrows0, int nrows, bf16_t* dst, const float* gw, const float* mod, int sh_off, int sc_off) {
    const int lane = threadIdx.x & 63, wid = threadIdx.x >> 6, RS = (int)gridDim.x * 8;
    for (int rowa = blockIdx.x * 8 + wid; rowa < nrows; rowa += 2 * RS) {
        const bool has2 = rowa + RS < nrows;
        int rows[2] = {rowa, has2 ? rowa + RS : rowa};
        f32x4 v[2][4];
#pragma unroll
        for (int u = 0; u < 2; ++u) { const int row = rows[u]; const float* s = row < nrows0 ? src0 + (size_t)row * 1024 : src1 + (size_t)(row - nrows0) * 1024;
            v[u][0] = *(const f32x4*)(s + 8 * lane); v[u][1] = *(const f32x4*)(s + 8 * lane + 4); v[u][2] = *(const f32x4*)(s + 512 + 8 * lane); v[u][3] = *(const f32x4*)(s + 512 + 8 * lane + 4); }
#pragma unroll
        for (int u = 0; u < 2; ++u) {
            if (u == 1 && !has2) break;
            const int row = rows[u]; const int mr = row < nrows0 ? row / SEQ : 8;
            float ss = 0.f;
#pragma unroll
            for (int i = 0; i < 4; ++i)
#pragma unroll
                for (int j = 0; j < 4; ++j) ss += v[u][i][j] * v[u][i][j];
            ss = wave_sum(ss);
            const float rs = rsqrtf(ss * (1.f / 1024.f) + 1e-6f);
            const float* mp = mod + (size_t)mr * 6144;
#pragma unroll
            for (int hh = 0; hh < 2; ++hh) { const int c = hh * 512 + 8 * lane; float o[8];
#pragma unroll
                for (int q = 0; q < 2; ++q) { const f32x4 gg = *(const f32x4*)(gw + c + 4 * q), sc = *(const f32x4*)(mp + sc_off + c + 4 * q), sh = *(const f32x4*)(mp + sh_off + c + 4 * q);
#pragma unroll
                    for (int j = 0; j < 4; ++j) o[4 * q + j] = (v[u][2 * hh + q][j] * rs * gg[j]) * (1.f + sc[j]) + sh[j]; }
                u32x4 w; w.x = pk_bf16(o[0], o[1]); w.y = pk_bf16(o[2], o[3]); w.z = pk_bf16(o[4], o[5]); w.w = pk_bf16(o[6], o[7]);
                *(u32x4*)(dst + (size_t)row * 1024 + c) = w; }
        }
    }
}
__device__ void phase_final(const Params& p) {
    const int lane = threadIdx.x & 63, wid = threadIdx.x >> 6, RS = (int)gridDim.x * 8;
    for (int rowa = blockIdx.x * 8 + wid; rowa < ML; rowa += 2 * RS) {
        const bool has2 = rowa + RS < ML;
        int rows[2] = {rowa, has2 ? rowa + RS : rowa};
        f32x4 v[2][4];
#pragma unroll
        for (int u = 0; u < 2; ++u) { const float* s = p.out + (size_t)rows[u] * 1024;
            v[u][0] = *(const f32x4*)(s + 8 * lane); v[u][1] = *(const f32x4*)(s + 8 * lane + 4); v[u][2] = *(const f32x4*)(s + 512 + 8 * lane); v[u][3] = *(const f32x4*)(s + 512 + 8 * lane + 4); }
#pragma unroll
        for (int u = 0; u < 2; ++u) {
            if (u == 1 && !has2) break;
            float* s = p.out + (size_t)rows[u] * 1024;
            float ss = 0.f;
#pragma unroll
            for (int i = 0; i < 4; ++i)
#pragma unroll
                for (int j = 0; j < 4; ++j) ss += v[u][i][j] * v[u][i][j];
            ss = wave_sum(ss);
            const float rs = rsqrtf(ss * (1.f / 1024.f) + 1e-6f);
#pragma unroll
            for (int i = 0; i < 4; ++i) { const int c = (i >> 1) * 512 + 8 * lane + 4 * (i & 1); const f32x4 gg = *(const f32x4*)(p.g_final + c); *(f32x4*)(s + c) = v[u][i] * rs * gg; }
        }
    }
}

constexpr int A_DD = 0, A_QR = 8192, A_KR = 25600, A_HT = 43008, A_QD = 45056, A_KD = 79872, A_P = 114688, A_VT = 8192;
constexpr int A_RS = 272;
constexpr int A_PS = 144;
constexpr float QSCALE = 0.08838834764831845f;

template <int DIR, bool LAT>
__device__ __forceinline__ void gla_pass2(LAS unsigned char* lds, const float (&la)[32], int ch, int half, float bmid, float start, bf16_t* kdg  ) {
    float kv[32], qv[32];
#pragma unroll
    for (int i = 0; i < 32; ++i) { const int t = half * 32 + i;
        kv[i] = bf2f(*(const LAS bf16_t*)(lds + A_KR + t * A_RS + ch * 2));
        qv[i] = LAT ? bf2f(*(const LAS bf16_t*)(lds + A_QR + t * A_RS + ch * 2)) * QSCALE : 0.f; }
    float b = start; unsigned kp[16];
#pragma unroll
    for (int s = 0; s < 32; ++s) {
        const int i = DIR == 0 ? s : 31 - s; const int t = half * 32 + i;
        b += la[i];
        const float e1 = __expf(b - bmid), e2 = __builtin_amdgcn_rcpf(e1);
        const float kd = kv[i] * e2;
        const unsigned kb = pk_bf16(kd, 0.f) & 0xffffu;
        if ((i & 1) == 0) kp[i >> 1] = (DIR == 0) ? kb : (kp[i >> 1] | kb); else kp[i >> 1] = (DIR == 0) ? (kp[i >> 1] | (kb << 16)) : (kb << 16);
        if (LAT) {
            *(LAS bf16_t*)(lds + A_QD + DIR * 17408 + t * A_RS + ch * 2) = f2bf(qv[i] * e1);
            *(LAS bf16_t*)(lds + A_KD + DIR * 17408 + t * A_RS + ch * 2) = (bf16_t)kb;
        }
    }
    const int kt = ch >> 4, fr = ch & 15;
#pragma unroll
    for (int g4 = 0; g4 < 4; ++g4) { u32x4 w; w.x = kp[4 * g4]; w.y = kp[4 * g4 + 1]; w.z = kp[4 * g4 + 2]; w.w = kp[4 * g4 + 3];
        *(u32x4*)(kdg + ((kt * 2 + half) * 64 + g4 * 16 + fr) * 8) = w; }
}

__device__ void phase_gla_a(const Params& p, LAS unsigned char* lds, int vbid) {
    const int tid = threadIdx.x, lane = tid & 63, wid = tid >> 6, fr = lane & 15, fq = lane >> 4;
    const float* dd = (const float*)(p.ws + OFF_DD);
    const bf16_t* qb = (const bf16_t*)(p.ws + OFF_Q); const bf16_t* kb = (const bf16_t*)(p.ws + OFF_K);
    bf16_t* vb = (bf16_t*)(p.ws + OFF_V);
    bf16_t* Q2 = (bf16_t*)(p.ws + OFF_U); bf16_t* K2L = (bf16_t*)p.out; bf16_t* VTL = (bf16_t*)p.out + (size_t)32 * 1024 * 1024;
    bf16_t* K2C = (bf16_t*)(p.ws + OFF_WFFI); bf16_t* VTC = (bf16_t*)(p.ws + OFF_WFFI) + (size_t)2 * 1024 * 1024; float* dec = (float*)(p.ws + OFF_DEC);
#define GA_DECODE(it_, lat_, b_, c_, h_, row0_, cidx_) do { lat_ = (it_) < 2048; \
        if (lat_) { b_ = (it_) >> 8; c_ = ((it_) & 255) >> 2; h_ = (it_) & 3; row0_ = (size_t)b_ * SEQ + c_ * 64; cidx_ = c_; } \
        else { const int j_ = (it_) - 2048; b_ = j_ >> 4; c_ = (j_ & 15) >> 2; h_ = j_ & 3; row0_ = (size_t)ML + b_ * CTXL + c_ * 64; cidx_ = 64 + c_; } } while (0)
#define GA_FETCH_A(it_) do { if ((it_) < 2048 + 128) { bool l_; int b_, c_, h_, ci_; size_t r0_; GA_DECODE(it_, l_, b_, c_, h_, r0_, ci_); (void)ci_; \
        pdd = *(const f32x4*)(dd + (r0_ + (tid >> 3)) * 32 + 4 * (tid & 7)); \
        _Pragma("unroll") for (int i = 0; i < 2; ++i) { const int pc = tid + 512 * i, r = pc >> 4, cp = pc & 15; \
            pk[i] = *(const u32x4*)(kb + (r0_ + r) * 512 + h_ * 128 + 8 * cp); if (l_) pq[i] = *(const u32x4*)(qb + (r0_ + r) * 512 + h_ * 128 + 8 * cp); } } } while (0)
#define GA_FETCH_V(it_) do { if ((it_) < 2048 + 128) { bool l_; int b_, c_, h_, ci_; size_t r0_; GA_DECODE(it_, l_, b_, c_, h_, r0_, ci_); (void)ci_; (void)l_; \
        _Pragma("unroll") for (int i = 0; i < 4; ++i) pv[i] = *(const u32x4*)(vb + (r0_ + lane) * 1024 + h_ * 256 + 8 * (wid + 8 * i)); } } while (0)
    f32x4 pdd = {0.f, 0.f, 0.f, 0.f}; u32x4 pk[2], pq[2], pv[4];
    pk[0] = pk[1] = pq[0] = pq[1] = pv[0] = pv[1] = pv[2] = pv[3] = (u32x4){0u, 0u, 0u, 0u};
    const int ch = tid & 127, dir = (tid >> 7) & 1, half = tid >> 8;
    float w[16], bias = 0.f; int hw = -1;
#pragma unroll
    for (int r = 0; r < 16; ++r) w[r] = 0.f;
    GA_FETCH_A(vbid); GA_FETCH_V(vbid);
    for (int it = vbid; it < 2048 + 128; it += gridDim.x) {
        bool lat; int b, c, h; size_t row0; int cidx;
        GA_DECODE(it, lat, b, c, h, row0, cidx);
        { const int r = tid >> 3, c4 = tid & 7; *(LAS f32x4*)(lds + A_DD + r * 128 + c4 * 16) = pdd; }
#pragma unroll
        for (int i = 0; i < 2; ++i) { const int pc = tid + 512 * i, r = pc >> 4, cp = pc & 15;
            *(LAS u32x4*)(lds + A_KR + r * A_RS + cp * 16) = pk[i];
            if (lat) *(LAS u32x4*)(lds + A_QR + r * A_RS + cp * 16) = pq[i]; }
        if (h != hw) {
#pragma unroll
            for (int r = 0; r < 16; ++r) w[r] = p.w_dec_up[(size_t)(dir * 16 + r) * 512 + h * 128 + ch];
            bias = p.b_dec[dir * 512 + h * 128 + ch]; hw = h; }
        GA_FETCH_A(it + (int)gridDim.x);
        __syncthreads();
        float la[32]; float tot = 0.f;
#pragma unroll
        for (int g = 0; g < 8; ++g) {
            f32x4 d[4][4];
#pragma unroll
            for (int tt = 0; tt < 4; ++tt) { const LAS f32x4* dp = (const LAS f32x4*)(lds + A_DD + (half * 32 + 4 * g + tt) * 128 + dir * 64);
#pragma unroll
                for (int q4 = 0; q4 < 4; ++q4) d[tt][q4] = dp[q4]; }
            asm volatile("" ::: "memory");
#pragma unroll
            for (int tt = 0; tt < 4; ++tt) { f32x2_t za = {bias, 0.f}, zb = {0.f, 0.f};
#pragma unroll
                for (int q4 = 0; q4 < 4; ++q4) { const f32x2_t dlo = {d[tt][q4][0], d[tt][q4][1]}, dhi = {d[tt][q4][2], d[tt][q4][3]};
                    const f32x2_t wlo = {w[4 * q4], w[4 * q4 + 1]}, whi = {w[4 * q4 + 2], w[4 * q4 + 3]};
                    za = __builtin_elementwise_fma(dlo, wlo, za); zb = __builtin_elementwise_fma(dhi, whi, zb); }
                const f32x2_t zs = za + zb; const float z = zs[0] + zs[1];
                const float l = (fminf(z, 0.f) - 0.69314718056f * __builtin_amdgcn_logf(1.f + __expf(-fabsf(z)))) * (1.f / 16.f);
                la[4 * g + tt] = l; tot += l; } }
        ((LAS float*)(lds + A_HT))[(dir * 2 + half) * 128 + ch] = tot;
        __syncthreads();
        { const float h0 = ((LAS float*)(lds + A_HT))[(dir * 2 + 0) * 128 + ch], h1 = ((LAS float*)(lds + A_HT))[(dir * 2 + 1) * 128 + ch];
            const float blast = h0 + h1, bmid = dir == 0 ? h0 : h1;
            const size_t cbase = (((size_t)dir * 8 + b) * 4 + h) * NCH + cidx;
            const size_t gb_ = ((size_t)dir * 8 + b) * 4 + h;
            bf16_t* kdg = lat ? K2L + (gb_ * 64 + c) * 8192 : K2C + (gb_ * 4 + c) * 8192;
            if (dir == 0) { if (lat) gla_pass2<0, true>(lds, la, ch, half, bmid, half ? h0 : 0.f, kdg); else gla_pass2<0, false>(lds, la, ch, half, bmid, half ? h0 : 0.f, kdg); }
            else { if (lat) gla_pass2<1, true>(lds, la, ch, half, bmid, half ? 0.f : h1, kdg); else gla_pass2<1, false>(lds, la, ch, half, bmid, half ? 0.f : h1, kdg); }
            if (half == 0) { float* sp = dec + cbase * 384 + ch; sp[0] = __expf(blast); sp[128] = __expf(blast - bmid); ((LAS float*)(lds + A_DD))[dir * 128 + ch] = __expf(bmid); } }
        __syncthreads();
#pragma unroll
        for (int i = 0; i < 4; ++i) { const int t = lane, cp = wid + 8 * i;
            const u32x4 vv = pv[i];
#pragma unroll
            for (int e = 0; e < 4; ++e) { *(LAS bf16_t*)(lds + A_VT + (8 * cp + 2 * e) * A_PS + t * 2) = (bf16_t)(vv[e] & 0xffffu); *(LAS bf16_t*)(lds + A_VT + (8 * cp + 2 * e + 1) * A_PS + t * 2) = (bf16_t)(vv[e] >> 16); } }
        GA_FETCH_V(it + (int)gridDim.x);
        if (lat) {
            const int rt = wid >> 1, ct0 = (wid & 1) * 2;
            f32x4 ps[2] = {{0.f, 0.f, 0.f, 0.f}, {0.f, 0.f, 0.f, 0.f}};
#pragma unroll
            for (int d = 0; d < 2; ++d)
#pragma unroll
                for (int cc = 0; cc < 2; ++cc) { const int ct = ct0 + cc; f32x4 a = {0.f, 0.f, 0.f, 0.f};
#pragma unroll
                    for (int ks = 0; ks < 4; ++ks) { const bf16x8 af = *(const LAS bf16x8*)(lds + A_QD + d * 17408 + (16 * rt + fr) * A_RS + (32 * ks + 8 * fq) * 2), bfr = *(const LAS bf16x8*)(lds + A_KD + d * 17408 + (16 * ct + fr) * A_RS + (32 * ks + 8 * fq) * 2);
                        a = __builtin_amdgcn_mfma_f32_16x16x32_bf16(af, bfr, a, 0, 0, 0); }
#pragma unroll
                    for (int r = 0; r < 4; ++r) { const int i = 16 * rt + 4 * fq + r, j = 16 * ct + fr; const bool keep = d == 0 ? (i >= j) : (j >= i); ps[cc][r] += keep ? a[r] : 0.f; } }
#pragma unroll
            for (int cc = 0; cc < 2; ++cc)
#pragma unroll
                for (int r = 0; r < 4; ++r) *(LAS bf16_t*)(lds + A_P + (16 * rt + 4 * fq + r) * A_PS + (16 * (ct0 + cc) + fr) * 2) = f2bf(ps[cc][r]);
        }
        __syncthreads();
        { bf16_t* vtg = lat ? VTL + (((size_t)b * 4 + h) * 64 + c) * 16384 : VTC + (((size_t)b * 4 + h) * 4 + c) * 16384;
#pragma unroll
            for (int i = 0; i < 4; ++i) { const int pc = tid + 512 * i, vc = pc >> 3, tp = pc & 7;
                *(u32x4*)(vtg + (((vc >> 4) * 2 + (tp >> 2)) * 64 + (tp & 3) * 16 + (vc & 15)) * 8) = *(const LAS u32x4*)(lds + A_VT + vc * A_PS + tp * 16); } }
        if (lat) {
#pragma unroll
            for (int d = 0; d < 2; ++d) { bf16_t* qg = Q2 + ((((size_t)d * 8 + b) * 4 + h) * 64 + c) * 8192;
#pragma unroll
                for (int i = 0; i < 2; ++i) { const int pc = tid + 512 * i, t = pc >> 4, cp = pc & 15;
                    const u32x4 qv = *(const LAS u32x4*)(lds + A_QD + d * 17408 + t * A_RS + cp * 16);
                    const f32x4 e0 = *(const LAS f32x4*)(lds + A_DD + (d * 128 + 8 * cp) * 4), e1 = *(const LAS f32x4*)(lds + A_DD + (d * 128 + 8 * cp + 4) * 4);
                    u32x4 w; w.x = pk_bf16(bf_lo(qv.x) * e0[0], bf_hi(qv.x) * e0[1]); w.y = pk_bf16(bf_lo(qv.y) * e0[2], bf_hi(qv.y) * e0[3]);
                    w.z = pk_bf16(bf_lo(qv.z) * e1[0], bf_hi(qv.z) * e1[1]); w.w = pk_bf16(bf_lo(qv.w) * e1[2], bf_hi(qv.w) * e1[3]);
                    *(u32x4*)(qg + (((t >> 4) * 4 + (cp >> 2)) * 64 + (cp & 3) * 16 + (t & 15)) * 8) = w; } }
        }
        if (lat) {
#pragma unroll
            for (int vv = 0; vv < 2; ++vv) { const int vct = 2 * wid + vv;
#pragma unroll
                for (int rt = 0; rt < 4; ++rt) { f32x4 a = {0.f, 0.f, 0.f, 0.f};
#pragma unroll
                    for (int ks = 0; ks < 2; ++ks) { const bf16x8 af = *(const LAS bf16x8*)(lds + A_VT + (16 * vct + fr) * A_PS + (32 * ks + 8 * fq) * 2), bfr = *(const LAS bf16x8*)(lds + A_P + (16 * rt + fr) * A_PS + (32 * ks + 8 * fq) * 2);
                        a = __builtin_amdgcn_mfma_f32_16x16x32_bf16(af, bfr, a, 0, 0, 0); }
                    u32x2 w; w.x = pk_bf16(a[0], a[1]); w.y = pk_bf16(a[2], a[3]);
                    *(u32x2*)(vb + (row0 + 16 * rt + fr) * 1024 + h * 256 + 16 * vct + 4 * fq) = w; } }
        }
        __syncthreads();
    }
}

constexpr int B_SLOT = 41984;
constexpr int B_ST = 2 * B_SLOT, B_STS = 272;
__device__ void phase_gla_b(const Params& p, LAS unsigned char* lds, int vbid) {
    const int tid = threadIdx.x, lane = tid & 63, wid = __builtin_amdgcn_readfirstlane(tid >> 6), fr = lane & 15, fq = lane >> 4;
    const bf16_t* QD = (const bf16_t*)(p.ws + OFF_U); const bf16_t* K2L = (const bf16_t*)p.out; const bf16_t* VTL = (const bf16_t*)p.out + (size_t)32 * 1024 * 1024;
    const bf16_t* K2C = (const bf16_t*)(p.ws + OFF_WFFI); const bf16_t* VTC = (const bf16_t*)(p.ws + OFF_WFFI) + (size_t)2 * 1024 * 1024; const float* scal = (const float*)(p.ws + OFF_DEC);
    bf16_t* of = (bf16_t*)(p.ws + OFF_Q); bf16_t* vb = (bf16_t*)(p.ws + OFF_V);
    const bool swave = wid < 4;
    const int kt0 = (wid & 3) * 2;
    const int rt0 = ((wid & 3) >> 1) * 2, vct0 = (wid & 1) * 2;
    for (int it = vbid; it < 256; it += gridDim.x) {
        const int grp = (it & 7) * 8 + ((it >> 3) >> 2), vs = (it >> 3) & 3, b = grp >> 3, h = (grp >> 1) & 3, dir = grp & 1;
        const size_t gbase = (((size_t)dir * 8 + b) * 4 + h);
        const bf16_t* k2l = K2L + gbase * 64 * 8192 + wid * 512 + lane * 8; const bf16_t* k2c = K2C + gbase * 4 * 8192 + wid * 512 + lane * 8;
        const bf16_t* vtl = VTL + (((size_t)b * 4 + h) * 64) * 16384 + (size_t)(vs * 8 + wid) * 512 + lane * 8; const bf16_t* vtc = VTC + (((size_t)b * 4 + h) * 4) * 16384 + (size_t)(vs * 8 + wid) * 512 + lane * 8;
        const bf16_t* q2b = QD + gbase * 64 * 8192 + wid * 512 + lane * 8;
        const float* dcb = scal + gbase * NCH * 384 + lane * 4;
        f32x4 S[2][4];
#pragma unroll
        for (int i = 0; i < 2; ++i)
#pragma unroll
            for (int j = 0; j < 4; ++j) S[i][j] = (f32x4){0.f, 0.f, 0.f, 0.f};
        u32x4 RA[6], RB[6]; u32x2 obA[2][2], obB[2][2];
#pragma unroll
        for (int a = 0; a < 2; ++a)
#pragma unroll
            for (int q = 0; q < 2; ++q) obA[a][q] = obB[a][q] = (u32x2){0u, 0u};
#define GB_STAGE(R, n_) do { const int nn_ = (n_) < NCH ? (n_) : NCH - 1; const int ci_ = dir == 0 ? (nn_ < 4 ? 64 + nn_ : nn_ - 4) : 67 - nn_; const int cq_ = nn_ < 4 ? 0 : (dir == 0 ? nn_ - 4 : 67 - nn_); \
            const bf16_t* kp_ = ci_ < 64 ? k2l + (size_t)ci_ * 8192 : k2c + (size_t)(ci_ - 64) * 8192; const bf16_t* vp_ = ci_ < 64 ? vtl + (size_t)ci_ * 16384 : vtc + (size_t)(ci_ - 64) * 16384; \
            R[0] = *(const u32x4*)(kp_); R[1] = *(const u32x4*)(kp_ + 8 * 512); R[2] = *(const u32x4*)(vp_); \
            R[3] = *(const u32x4*)(q2b + (size_t)cq_ * 8192); R[4] = *(const u32x4*)(q2b + (size_t)cq_ * 8192 + 8 * 512); \
            if (wid == 0) R[5] = *(const u32x4*)(dcb + (size_t)ci_ * 384); } while (0)
#define GB_OBLOAD(OB, n_) do { if (!swave && dir == 1 && (n_) >= 4 && (n_) < NCH) { const int ncl_ = 67 - (n_); \
            _Pragma("unroll") for (int a = 0; a < 2; ++a) _Pragma("unroll") for (int q = 0; q < 2; ++q) \
                OB[a][q] = *(const u32x2*)(vb + ((size_t)b * SEQ + ncl_ * 64 + 16 * (rt0 + a) + fr) * 1024 + h * 256 + vs * 64 + 16 * (vct0 + q) + 4 * fq); } } while (0)
#define GB_STEP(R, OB, n) do { \
            const bool lat = (n) >= 4; const int cl = dir == 0 ? (n) - 4 : 67 - (n); \
            LAS unsigned char* slot = lds + ((n) & 1) * B_SLOT; \
            LAS unsigned char* st = lds + B_ST + ((n) & 1) * 17408; \
            *(LAS u32x4*)(slot + wid * 1024 + lane * 16) = R[0]; *(LAS u32x4*)(slot + (wid + 8) * 1024 + lane * 16) = R[1]; *(LAS u32x4*)(slot + 16384 + wid * 1024 + lane * 16) = R[2]; \
            *(LAS u32x4*)(slot + 24576 + wid * 1024 + lane * 16) = R[3]; *(LAS u32x4*)(slot + 24576 + (wid + 8) * 1024 + lane * 16) = R[4]; \
            if (wid == 0) *(LAS u32x4*)(slot + 40960 + lane * 16) = R[5]; \
            if (lat && swave) { \
                _Pragma("unroll") for (int i = 0; i < 2; ++i) \
                    _Pragma("unroll") for (int j = 0; j < 4; ++j) { const f32x4 sv = S[i][j]; u32x2 w; w.x = pk_bf16(sv[0], sv[1]); w.y = pk_bf16(sv[2], sv[3]); \
                        *(LAS u32x2*)(st + (16 * j + fr) * B_STS + (16 * (kt0 + i) + 4 * fq) * 2) = w; } } \
            GB_STAGE(R, (n) + 2); \
            __syncthreads(); \
            if (swave) { \
                bf16x8 kfr[2][2]; \
                _Pragma("unroll") for (int i = 0; i < 2; ++i) _Pragma("unroll") for (int ks = 0; ks < 2; ++ks) kfr[i][ks] = *(const LAS bf16x8*)(slot + ((kt0 + i) * 2 + ks) * 1024 + lane * 16); \
                f32x4 dcv[2], elv[2]; \
                _Pragma("unroll") for (int i = 0; i < 2; ++i) { dcv[i] = *(const LAS f32x4*)(slot + 40960 + (16 * (kt0 + i) + 4 * fq) * 4); elv[i] = *(const LAS f32x4*)(slot + 40960 + 512 + (16 * (kt0 + i) + 4 * fq) * 4); } \
                _Pragma("unroll") for (int j = 0; j < 4; ++j) { \
                    const bf16x8 vf0 = *(const LAS bf16x8*)(slot + 16384 + (j * 2 + 0) * 1024 + lane * 16), vf1 = *(const LAS bf16x8*)(slot + 16384 + (j * 2 + 1) * 1024 + lane * 16); \
                    _Pragma("unroll") for (int i = 0; i < 2; ++i) { f32x4 pacc = {0.f, 0.f, 0.f, 0.f}; \
                        pacc = __builtin_amdgcn_mfma_f32_16x16x32_bf16(kfr[i][0], vf0, pacc, 0, 0, 0); pacc = __builtin_amdgcn_mfma_f32_16x16x32_bf16(kfr[i][1], vf1, pacc, 0, 0, 0); \
                        S[i][j] = S[i][j] * dcv[i] + pacc * elv[i]; } } \
            } else if (lat) { \
                bf16x8 qfr[2][4]; \
                _Pragma("unroll") for (int a = 0; a < 2; ++a) _Pragma("unroll") for (int ks = 0; ks < 4; ++ks) qfr[a][ks] = *(const LAS bf16x8*)(slot + 24576 + ((rt0 + a) * 4 + ks) * 1024 + lane * 16); \
                _Pragma("unroll") for (int q = 0; q < 2; ++q) { bf16x8 sfr[4]; \
                    _Pragma("unroll") for (int ks = 0; ks < 4; ++ks) sfr[ks] = *(const LAS bf16x8*)(st + (16 * (vct0 + q) + fr) * B_STS + (32 * ks + 8 * fq) * 2); \
                    _Pragma("unroll") for (int a = 0; a < 2; ++a) { f32x4 acc = {0.f, 0.f, 0.f, 0.f}; \
                        _Pragma("unroll") for (int ks = 0; ks < 4; ++ks) acc = __builtin_amdgcn_mfma_f32_16x16x32_bf16(sfr[ks], qfr[a][ks], acc, 0, 0, 0); \
                        const size_t off = ((size_t)b * SEQ + cl * 64 + 16 * (rt0 + a) + fr) * 1024 + h * 256 + vs * 64 + 16 * (vct0 + q) + 4 * fq; \
                        if (dir == 0) { u32x2 w; w.x = pk_bf16(acc[0], acc[1]); w.y = pk_bf16(acc[2], acc[3]); *(u32x2*)(of + off) = w; } \
                        else { const u32x2 o = OB[a][q]; u32x2 w; w.x = pk_bf16(acc[0] + bf_lo(o.x), acc[1] + bf_hi(o.x)); w.y = pk_bf16(acc[2] + bf_lo(o.y), acc[3] + bf_hi(o.y)); *(u32x2*)(vb + off) = w; } } } \
            } \
            GB_OBLOAD(OB, (n) + 2); } while (0)
        RA[5] = RB[5] = (u32x4){0u, 0u, 0u, 0u};
        GB_STAGE(RA, 0); GB_STAGE(RB, 1); GB_OBLOAD(obA, 4); GB_OBLOAD(obB, 5);
#pragma unroll 1
        for (int n = 0; n < NCH; n += 2) { GB_STEP(RA, obA, n); GB_STEP(RB, obB, n + 1); }
        __syncthreads();
#undef GB_STEP
#undef GB_OBLOAD
#undef GB_STAGE
    }
}

__device__ void phase_agla(const Params& p) {
    const int lane = threadIdx.x & 63, wid = threadIdx.x >> 6, sub = lane >> 5, l32 = lane & 31;
    const bf16_t* o1 = (const bf16_t*)(p.ws + OFF_V); const bf16_t* o2 = (const bf16_t*)(p.ws + OFF_Q); bf16_t* g = (bf16_t*)(p.ws + OFF_G);
    const f32x4 gh0 = *(const f32x4*)(p.g_head + 8 * l32), gh1 = *(const f32x4*)(p.g_head + 8 * l32 + 4);
    for (int i0 = (blockIdx.x * 8 + wid) * 8; i0 < ML * 4; i0 += gridDim.x * 64) {
        u32x4 a[4], b[4], gs[4]; size_t off[4];
#pragma unroll
        for (int st = 0; st < 4; ++st) { const int idx = i0 + 2 * st + sub; off[st] = (size_t)(idx >> 2) * 1024 + (idx & 3) * 256 + 8 * l32;
            a[st] = *(const u32x4*)(o1 + off[st]); b[st] = *(const u32x4*)(o2 + off[st]); gs[st] = *(const u32x4*)(g + off[st]); }
#pragma unroll
        for (int st = 0; st < 4; ++st) {
            float o[8];
#pragma unroll
            for (int e = 0; e < 4; ++e) { o[2 * e] = bf_lo(a[st][e]) + bf_lo(b[st][e]); o[2 * e + 1] = bf_hi(a[st][e]) + bf_hi(b[st][e]); }
            float ss = 0.f;
#pragma unroll
            for (int e = 0; e < 8; ++e) ss += o[e] * o[e];
#pragma unroll
            for (int m = 16; m > 0; m >>= 1) ss += __shfl_xor(ss, m);
            const float rs = rsqrtf(ss * (1.f / 256.f) + 1e-6f);
            float r[8];
#pragma unroll
            for (int e = 0; e < 4; ++e) { r[2 * e] = o[2 * e] * rs * (e < 2 ? gh0[2 * e] : gh1[2 * e - 4]) * bf_lo(gs[st][e]); r[2 * e + 1] = o[2 * e + 1] * rs * (e < 2 ? gh0[2 * e + 1] : gh1[2 * e - 3]) * bf_hi(gs[st][e]); }
            u32x4 w; w.x = pk_bf16(r[0], r[1]); w.y = pk_bf16(r[2], r[3]); w.z = pk_bf16(r[4], r[5]); w.w = pk_bf16(r[6], r[7]);
            *(u32x4*)(g + off[st]) = w;
        }
    }
}

__device__ void ffn_bias(const Params& p) {
    const int lane = threadIdx.x & 63, wid = threadIdx.x >> 6;
    const bf16_t* W = (const bf16_t*)(p.ws + OFF_WFFI); const float* mod = (const float*)(p.ws + OFF_MOD); float* bias2 = (float*)(p.ws + OFF_BIAS2);
    for (int n = blockIdx.x * 8 + wid; n < 2 * DFF; n += gridDim.x * 8) {
        const u32x4 w0 = *(const u32x4*)(W + (size_t)n * 1024 + 8 * lane), w1 = *(const u32x4*)(W + (size_t)n * 1024 + 512 + 8 * lane);
        float wv[16];
#pragma unroll
        for (int e = 0; e < 4; ++e) { wv[2 * e] = bf_lo(w0[e]); wv[2 * e + 1] = bf_hi(w0[e]); wv[8 + 2 * e] = bf_lo(w1[e]); wv[8 + 2 * e + 1] = bf_hi(w1[e]); }
#pragma unroll
        for (int b = 0; b < 8; ++b) { const float* sp = mod + (size_t)b * 6144 + 3072; float a = 0.f;
#pragma unroll
            for (int q = 0; q < 2; ++q) { const f32x4 s0 = *(const f32x4*)(sp + 8 * lane + 4 * q), s1 = *(const f32x4*)(sp + 512 + 8 * lane + 4 * q);
#pragma unroll
                for (int j = 0; j < 4; ++j) a += s0[j] * wv[4 * q + j] + s1[j] * wv[8 + 4 * q + j]; }
            a = wave_sum(a);
            if (lane == 0) bias2[(size_t)b * (2 * DFF) + n] = a; }
    }
}
__device__ void zero_rowss(const Params& p) {
    float* r = (float*)(p.ws + OFF_ROWSS);
    for (int i = blockIdx.x * 512 + threadIdx.x; i < ML; i += gridDim.x * 512) r[i] = 0.f;
}

__device__ __forceinline__ void run_phase(const Params& p, LAS unsigned char* lds, int ph, int vbid) {
    unsigned char* ws = p.ws; const float* mod = (const float*)(ws + OFF_MOD);
    const int G = (int)gridDim.x, c = vbid;
    switch (ph) {
    case 0: phase_prep(p, lds); break;
    case 1: norm_mod_rows(p.x, p.ctx, ML, MT, (bf16_t*)p.out, p.g_mix, mod, 0, 1024); break;
    case 2: { pg8::Gemm g{(const bf16_t*)p.out, (const bf16_t*)(ws + OFF_WIN), MT, NINP, 1024, 16}; pg8::InOrder S; S.init(G, c);
        EpiInProj E{(bf16_t*)(ws + OFF_Q), (bf16_t*)(ws + OFF_K), (bf16_t*)(ws + OFF_V), (bf16_t*)(ws + OFF_G), (bf16_t*)(ws + OFF_CB), (bf16_t*)(ws + OFF_GA), (bf16_t*)(ws + OFF_GB), (float*)(ws + OFF_DD), p.w_conv};
        pg8::gemm_phase(lds, g, S, E); } break;
    case 5: phase_gla_a(p, lds, vbid); break;
    case 6: phase_gla_b(p, lds, vbid); break;
    case 7: wconv_run(p, lds, WT_MIX_END, WT_END); zero_rowss(p); phase_agla(p); break;
    case 8: { ffn_bias(p); pg8::Gemm g{(const bf16_t*)(ws + OFF_CB), (const bf16_t*)(ws + OFF_WCONV), ML, 1024, 1024, 16}; pg8::DualOrder S; S.init(ML, 1024, G, c);
        EpiDual E{(bf16_t*)(ws + OFF_U), (const bf16_t*)(ws + OFF_GA), (const bf16_t*)(ws + OFF_GB)}; pg8::gemm_phase(lds, g, S, E); } break;
    case 9: { pg8::Gemm g{(const bf16_t*)(ws + OFF_U), (const bf16_t*)(ws + OFF_WMIX), ML, 1024, 1024, 16}; pg8::StaticOrder S; S.init(ML, 1024, G, c);
        EpiMix E{p.x, p.out, mod, p.g_ffn, (bf16_t*)(ws + OFF_G), (float*)(ws + OFF_ROWSS)}; pg8::gemm_phase(lds, g, S, E); } break;
    case 11: { pg8::Gemm g{(const bf16_t*)(ws + OFF_G), (const bf16_t*)(ws + OFF_WFFI), ML, 2 * DFF, 1024, 16}; pg8::StaticOrder S; S.init(ML, 2 * DFF, G, c);
        EpiFfnIn E{(bf16_t*)(ws + OFF_GA), (const float*)(ws + OFF_ROWSS), (const float*)(ws + OFF_BIAS2)}; pg8::gemm_phase(lds, g, S, E); } break;
    case 12: { pg8::Gemm g{(const bf16_t*)(ws + OFF_GA), (const bf16_t*)(ws + OFF_WFFO), ML, 1024, DFF, DFF / 64}; pg8::StaticOrder S; S.init(ML, 1024, G, c);
        EpiRes E{p.out, p.out, mod + 5120}; pg8::gemm_phase(lds, g, S, E); } break;
    case 13: phase_final(p); break;
    default: break;
    }
}

#if FUSED
__global__ void __launch_bounds__(512, 2) mega_fwd(Params p) {
    extern __shared__ __attribute__((aligned(16))) unsigned char shm[];
    LAS unsigned char* lds = (LAS unsigned char*)shm;
    volatile LAS unsigned* xst = (volatile LAS unsigned*)(lds + LDS_STAGE);
    if (threadIdx.x == 0) { xst[0] = 0u; xst[1] = 0u; xst[2] = 0u; xst[3] = 0u; }
    __syncthreads();
    const XcdBarrier xb = xcd_barrier_post((unsigned*)(p.ws + OFF_BAR), xst);
    if (threadIdx.x == 0) xst[2] = xb_add(&xb.bar[xb.x], 1u);
    int vbid = (int)blockIdx.x;
#define VBID_SETUP() do { if (threadIdx.x == 0) { unsigned cnt[16], tot = 0u, nx = 0u, pre = 0u, kx = 0u; bool eq = true; \
        _Pragma("unroll") for (unsigned j = 0; j < 16; ++j) { cnt[j] = xb_ld(&xb.bar[XB_XCNT(j)]); } \
        _Pragma("unroll") for (unsigned j = 0; j < 16; ++j) { if (cnt[j]) { if (j < xb.x) { pre += cnt[j]; ++kx; } ++nx; tot += cnt[j]; eq = eq && (cnt[j] == cnt[xb.x]); } } \
        const unsigned rank = xst[2]; xst[3] = (eq && tot == gridDim.x && nx == 8u) ? rank * 8u + kx : pre + rank; } \
        __syncthreads(); vbid = (int)xst[3]; if (vbid < 0 || vbid >= (int)gridDim.x) vbid = (int)blockIdx.x; } while (0)
#define GSYNC(n) do { xcd_barrier(xb); if ((n) == 0) VBID_SETUP(); } while (0)
#ifdef TPROBE
    unsigned long long tsum_sync = 0, tsum_sel = 0, t0, t1;
#define PH(n) t0 = __builtin_amdgcn_s_memrealtime(); run_phase(p, lds, n, vbid); asm volatile("" ::: "memory"); t1 = __builtin_amdgcn_s_memrealtime(); if ((TPROBE_MASK >> (n)) & 1) tsum_sel += t1 - t0; \
    GSYNC(n); asm volatile("" ::: "memory"); t0 = __builtin_amdgcn_s_memrealtime(); tsum_sync += t0 - t1;
    PH(0) PH(1) PH(2) PH(5) PH(6) PH(7) PH(8) PH(9) PH(11) PH(12)
    t0 = __builtin_amdgcn_s_memrealtime(); run_phase(p, lds, 13, vbid); t1 = __builtin_amdgcn_s_memrealtime(); if ((TPROBE_MASK >> 13) & 1) tsum_sel += t1 - t0;
    if (blockIdx.x == 0) { const unsigned long long want = 2ull * (TPROBE_SYNC ? tsum_sync : tsum_sel); const unsigned long long ts = __builtin_amdgcn_s_memrealtime();
        while (__builtin_amdgcn_s_memrealtime() - ts < want) __builtin_amdgcn_s_sleep(8); }
#undef PH
#else
#define PH(n) run_phase(p, lds, n, vbid); asm volatile("" ::: "memory"); GSYNC(n); asm volatile("" ::: "memory");
    PH(0) PH(1) PH(2) PH(5) PH(6) PH(7) PH(8) PH(9) PH(11) PH(12)
    run_phase(p, lds, 13, vbid);
#undef PH
#endif
}
#else
__global__ void __launch_bounds__(512, 2) mega_fwd(Params p, int ph) {
    extern __shared__ __attribute__((aligned(16))) unsigned char shm[];
    LAS unsigned char* lds = (LAS unsigned char*)shm;
    run_phase(p, lds, ph, (int)blockIdx.x);
}
#endif

extern "C" void kernel_launch(void* const* d_in, const int* in_sizes, int n_in, void* d_out, int out_size, void* d_ws, size_t ws_size, hipStream_t stream) {
    static int grid = 0;
    if (grid == 0) {
        if (n_in != 19 || out_size != ML * DM || ws_size < WS_NEED) { fprintf(stderr, "kernel_launch: unexpected shapes (n_in %d out %d ws %zu need %zu)\n", n_in, out_size, ws_size, (size_t)WS_NEED); grid = -1; return; }
        int dev = 0, cus = 0, per_cu = 0;
        (void)hipGetDevice(&dev); (void)hipDeviceGetAttribute(&cus, hipDeviceAttributeMultiprocessorCount, dev);
        if (hipFuncSetAttribute((const void*)mega_fwd, hipFuncAttributeMaxDynamicSharedMemorySize, LDS_BYTES) != hipSuccess) { fprintf(stderr, "hipFuncSetAttribute failed\n"); grid = -1; return; }
        if (hipOccupancyMaxActiveBlocksPerMultiprocessor(&per_cu, (const void*)mega_fwd, 512, LDS_BYTES) != hipSuccess || per_cu < 1) { fprintf(stderr, "occupancy query failed (%d)\n", per_cu); (void)hipGetLastError(); per_cu = 1; }
        if (per_cu > 1) per_cu = 1;
        grid = cus * per_cu;
    }
    if (grid < 0) return;
    Params p{};
    const float** f = (const float**)&p;
    for (int i = 0; i < 19; ++i) f[i] = (const float*)d_in[i];
    p.out = (float*)d_out; p.ws = (unsigned char*)d_ws;
#if FUSED
    (void)hipMemsetAsync((char*)d_ws + OFF_BAR, 0, BAR_BYTES, stream);
    void* args[] = {&p};
    hipError_t e = hipLaunchCooperativeKernel((const void*)mega_fwd, dim3(grid), dim3(512), args, LDS_BYTES, stream);
    if (e != hipSuccess) fprintf(stderr, "cooperative launch failed: %s (grid %d)\n", hipGetErrorString(e), grid);
#else
    for (int ph = 0; ph < NPHASE; ++ph) hipLaunchKernelGGL(mega_fwd, dim3(grid), dim3(512), LDS_BYTES, stream, p, ph);
#endif
}
```
